# Optimizing an MI355X kernel written in HIP

```python
import jax
import jax.numpy as jnp
from jax import lax
import numpy as np

D_MODEL = 1024
BATCH = 8
SEQ = 4096
DEPTH = 1

HEAD_DIM = 64
ATTN_WIDTH = D_MODEL // 2
N_ATTN_HEADS = ATTN_WIDTH // HEAD_DIM
N_KV_HEADS = 2
KV_WIDTH = N_KV_HEADS * HEAD_DIM
WINDOW = 128
BLOCK = 128
ROPE_THETA = 500000.0
ROTARY_DIM = HEAD_DIM // 4
POOL_WINDOWS = (2, 4, 8, 16)
N_POOL_GROUPS = len(POOL_WINDOWS)
POOL_WIDTH = D_MODEL // 2
POOL_GROUP_WIDTH = POOL_WIDTH // N_POOL_GROUPS
MIX_WIDTH = ATTN_WIDTH + POOL_WIDTH
IN_WIDTH = ATTN_WIDTH + 2 * KV_WIDTH + POOL_WIDTH
D_FF = 2816
EPS = 1e-6

kernel_name = 'hybrid_window_gqa_multiscale_pool_macaron'


def rms_norm(x, g):
    xf = x.astype(jnp.float32)
    y = xf * lax.rsqrt(jnp.mean(xf * xf, axis=-1, keepdims=True) + EPS)
    return (y * g.astype(jnp.float32)).astype(x.dtype)


def swiglu(x, w_gate, w_up, w_down):
    return (jax.nn.silu(x @ w_gate) * (x @ w_up)) @ w_down


def rope_tables(positions):
    inv_freq = ROPE_THETA ** (-jnp.arange(0, ROTARY_DIM, 2, dtype=jnp.float32) / ROTARY_DIM)
    ang = positions.astype(jnp.float32)[:, None] * inv_freq[None, :]
    emb = jnp.concatenate([ang, ang], axis=-1)
    return jnp.cos(emb)[None, :, None, :], jnp.sin(emb)[None, :, None, :]


def apply_partial_rope(t, cos, sin):
    tf = t.astype(jnp.float32)
    rot, rest = tf[..., :ROTARY_DIM], tf[..., ROTARY_DIM:]
    half = ROTARY_DIM // 2
    rot_half = jnp.concatenate([-rot[..., half:], rot[..., :half]], axis=-1)
    rot = rot * cos + rot_half * sin
    return jnp.concatenate([rot, rest], axis=-1).astype(t.dtype)


def window_attention(q, k, v, sink):
    B, S, H, D = q.shape
    nb = S // BLOCK
    G = H // N_KV_HEADS
    qb = q.reshape(B, nb, BLOCK, N_KV_HEADS, G, D)

    def bands(t):
        tp = jnp.pad(t, ((0, 0), (BLOCK, BLOCK), (0, 0), (0, 0)))
        tb = tp.reshape(B, nb + 2, BLOCK, N_KV_HEADS, D)
        return jnp.concatenate([tb[:, :-2], tb[:, 1:-1], tb[:, 2:]], axis=2)

    kb, vb = bands(k), bands(v)
    scores = jnp.einsum('bnqkgd,bnskd->bnkgqs', qb, kb,
                        preferred_element_type=jnp.float32) * (D ** -0.5)
    qpos = jnp.arange(nb)[:, None] * BLOCK + jnp.arange(BLOCK)[None, :]
    kpos = jnp.arange(nb)[:, None] * BLOCK + jnp.arange(3 * BLOCK)[None, :] - BLOCK
    dist = qpos[:, :, None] - kpos[:, None, :]
    valid = (jnp.abs(dist) <= WINDOW) & (kpos[:, None, :] >= 0) & (kpos[:, None, :] < S)
    scores = jnp.where(valid[None, :, None, None], scores, -1e30)
    sink_l = sink.astype(jnp.float32).reshape(N_KV_HEADS, G)[None, None, :, :, None, None]
    m = jnp.maximum(jnp.max(scores, axis=-1, keepdims=True), sink_l)
    p = jnp.exp(scores - m)
    denom = jnp.sum(p, axis=-1, keepdims=True) + jnp.exp(sink_l - m)
    p = (p / denom).astype(v.dtype)
    out = jnp.einsum('bnkgqs,bnskd->bnqkgd', p, vb)
    return out.reshape(B, S, H * D)


def multiscale_pool(u, w_pool, pool_scale):
    B, S, _ = u.shape
    uf = u.astype(jnp.float32)
    csum = jnp.concatenate([jnp.zeros((B, 1, POOL_WIDTH), jnp.float32),
                            jnp.cumsum(uf, axis=1)], axis=1)
    t = jnp.arange(S)
    means = []
    for gi, w in enumerate(POOL_WINDOWS):
        cg = csum[..., gi * POOL_GROUP_WIDTH:(gi + 1) * POOL_GROUP_WIDTH]
        half = w // 2

        def win_mean(lo, hi):
            a = jnp.clip(lo, 0, S)
            b = jnp.clip(hi + 1, 0, S)
            s = jnp.take(cg, b, axis=1) - jnp.take(cg, a, axis=1)
            return s / (b - a).astype(jnp.float32)[None, :, None]

        means.append(0.5 * (win_mean(t - half, t + half - 1) + win_mean(t - half + 1, t + half)))
    mean = jnp.concatenate(means, axis=-1)
    d = (mean - uf).reshape(B, S, N_POOL_GROUPS, POOL_GROUP_WIDTH)
    y = jnp.einsum('bsgc,gcd->bsgd', d, w_pool.astype(jnp.float32)).reshape(B, S, POOL_WIDTH)
    return (y * pool_scale.astype(jnp.float32)).astype(u.dtype)


def setup_inputs(seed: int = 0) -> dict:
    key = jax.random.key(seed)
    ks = jax.random.split(key, 18)
    f32 = jnp.float32
    L = DEPTH

    def nrm(k, shape, scale):
        return jax.random.normal(k, shape, f32) * scale

    def gain(k, shape, s=0.05):
        return 1.0 + s * jax.random.normal(k, shape, f32)

    return {
        'x': nrm(ks[0], (BATCH, SEQ, D_MODEL), 1.0),
        'ffn1_norm': gain(ks[1], (L, D_MODEL)),
        'ffn1_w_gate': nrm(ks[2], (L, D_MODEL, D_FF), D_MODEL ** -0.5),
        'ffn1_w_up': nrm(ks[3], (L, D_MODEL, D_FF), D_MODEL ** -0.5),
        'ffn1_w_down': nrm(ks[4], (L, D_FF, D_MODEL), D_FF ** -0.5),
        'mix_norm': gain(ks[5], (L, D_MODEL)),
        'w_in': nrm(ks[6], (L, D_MODEL, IN_WIDTH), D_MODEL ** -0.5),
        'sink_logits': nrm(ks[7], (L, N_ATTN_HEADS), 0.5),
        'pool_w': nrm(ks[8], (L, N_POOL_GROUPS, POOL_GROUP_WIDTH, POOL_GROUP_WIDTH), POOL_GROUP_WIDTH ** -0.5),
        'pool_scale': gain(ks[9], (L, POOL_WIDTH), 0.1),
        'w_out': nrm(ks[10], (L, MIX_WIDTH, D_MODEL), MIX_WIDTH ** -0.5),
        'ffn2_norm': gain(ks[11], (L, D_MODEL)),
        'ffn2_w_gate': nrm(ks[12], (L, D_MODEL, D_FF), D_MODEL ** -0.5),
        'ffn2_w_up': nrm(ks[13], (L, D_MODEL, D_FF), D_MODEL ** -0.5),
        'ffn2_w_down': nrm(ks[14], (L, D_FF, D_MODEL), D_FF ** -0.5),
        'final_norm': gain(ks[15], (D_MODEL,)),
    }


def reference(x, ffn1_norm, ffn1_w_gate, ffn1_w_up, ffn1_w_down, mix_norm, w_in,
              sink_logits, pool_w, pool_scale, w_out, ffn2_norm, ffn2_w_gate,
              ffn2_w_up, ffn2_w_down, final_norm):
    B, S, _ = x.shape
    positions = jnp.arange(S, dtype=jnp.int32)
    cos, sin = rope_tables(positions)
    h = x
    for l in range(DEPTH):
        h = h + 0.5 * swiglu(rms_norm(h, ffn1_norm[l]), ffn1_w_gate[l], ffn1_w_up[l], ffn1_w_down[l])
        u = rms_norm(h, mix_norm[l]) @ w_in[l]
        q, k, v, pc = jnp.split(u, [ATTN_WIDTH, ATTN_WIDTH + KV_WIDTH, ATTN_WIDTH + 2 * KV_WIDTH], axis=-1)
        q = apply_partial_rope(q.reshape(B, S, N_ATTN_HEADS, HEAD_DIM), cos, sin)
        k = apply_partial_rope(k.reshape(B, S, N_KV_HEADS, HEAD_DIM), cos, sin)
        v = v.reshape(B, S, N_KV_HEADS, HEAD_DIM)
        a = window_attention(q, k, v, sink_logits[l])
        p = multiscale_pool(pc, pool_w[l], pool_scale[l])
        h = h + jnp.concatenate([a, p], axis=-1) @ w_out[l]
        h = h + 0.5 * swiglu(rms_norm(h, ffn2_norm[l]), ffn2_w_gate[l], ffn2_w_up[l], ffn2_w_down[l])
    return rms_norm(h, final_norm)
```

```cpp
#include <hip/hip_runtime.h>
#include <hip/hip_cooperative_groups.h>
#include <cstdio>
#include <cstdint>
namespace cg = cooperative_groups;
namespace pg8 {
#define PG8_LAS __attribute__((address_space(3)))
typedef unsigned short bf16_t;
typedef short bf16x8 __attribute__((ext_vector_type(8)));
typedef float f32x4 __attribute__((ext_vector_type(4)));
typedef unsigned u32x4 __attribute__((ext_vector_type(4)));
constexpr int BM = 256, BK = 64, HALF = 128, HTB = HALF * BK * 2  , STAGE_BYTES = 8 * HTB, NXCD = 8, WGM = 8;

__host__ __device__ __forceinline__ int lds_byte(int r, int c) { const int st = (r >> 4) * 2 + (c >> 5), rr = r & 15, cc = c & 31, ob = rr * 64 + cc * 2; return st * 1024 + (ob ^ (((ob >> 9) & 1) << 5)); }
__host__ __device__ __forceinline__ void stage_rc(int b, int& R, int& C) { const int st = b / 1024, sb = b % 1024, swz = sb ^ (((sb >> 9) & 1) << 5); R = (st >> 1) * 16 + swz / 64; C = (st & 1) * 32 + (swz % 64) / 2; }
__host__ __device__ __forceinline__ int perm32(int rho) { const int n = rho >> 4, i = rho & 15; return 8 * (i >> 2) + 4 * n + (i & 3); }

struct Unit { int pm, pn; };
struct Gemm { const bf16_t* A; const bf16_t* Bt; int M, N, K; };

struct StaticOrder {
    int nM, nN, nwg, G, c;
    __host__ __device__ void init(int M, int N, int G_, int c_) { nM = M / BM; nN = N / BM; nwg = nM * nN; G = G_; c = c_; }
    __host__ __device__ bool next(int i, Unit& u) const {
        const long L = (long)i * G + c; if (L >= nwg) return false;
        int wgid = (int)L; { const int q = nwg / NXCD, r = nwg % NXCD, xcd = wgid % NXCD, off = wgid / NXCD; wgid = (xcd < r ? xcd * (q + 1) : r * (q + 1) + (xcd - r) * q) + off; }
        const int nig = WGM * nN, gid = wgid / nig, fm = gid * WGM, gsz = (nM - fm) < WGM ? (nM - fm) : WGM;
        u.pm = fm + ((wgid % nig) % gsz); u.pn = (wgid % nig) / gsz; return true;
    }
    __device__ __forceinline__ void a_ready(const Unit&) const {}
    __device__ __forceinline__ void done(const Unit&) const {}
};

__device__ __forceinline__ unsigned cvt_pk_bf16(float lo, float hi) { unsigned r; asm volatile("v_cvt_pk_bf16_f32 %0, %1, %2" : "=v"(r) : "v"(lo), "v"(hi)); return r; }
constexpr float RMS_EPS = 1e-6f;
__device__ __forceinline__ float row_rs(const float* ss, int row) {
    const f32x4* p = (const f32x4*)(ss + (size_t)row * 16);
    const f32x4 a = p[0], b = p[1], c = p[2], d = p[3];
    const f32x4 s = (a + b) + (c + d);
    const float t = (s[0] + s[1]) + (s[2] + s[3]);
    return 1.0f / sqrtf(t * (1.0f / 1024.0f) + RMS_EPS);
}
__device__ __forceinline__ float silu_mul(float g, float u) {
    const float e = __builtin_amdgcn_exp2f(g * -1.44269504089f);
    return g * __builtin_amdgcn_rcpf(1.0f + e) * u;
}
struct EpiSwiglu {
    static constexpr bool PERM = true, AFTER_DRAIN = false;
    bf16_t* O; int ldc; const float* ss;
    __device__ __forceinline__ void operator()(const f32x4 (&acc)[2][2][4][2], const Unit& u, int wr, int wc, int fr, int fq) const {
        const int row0 = u.pm * BM + wr * 64 + fr; const int col0 = u.pn * HALF + wc * 32 + 8 * fq;
#pragma unroll
        for (int ai = 0; ai < 2; ++ai)
#pragma unroll
            for (int m = 0; m < 4; ++m) {
                const int row = row0 + ai * HALF + m * 16; const float rs = row_rs(ss, row);
                const f32x4 g0 = acc[ai][0][m][0] * rs, g1 = acc[ai][0][m][1] * rs, u0 = acc[ai][1][m][0] * rs, u1 = acc[ai][1][m][1] * rs;
                u32x4 w;
                w.x = cvt_pk_bf16(silu_mul(g0[0], u0[0]), silu_mul(g0[1], u0[1])); w.y = cvt_pk_bf16(silu_mul(g0[2], u0[2]), silu_mul(g0[3], u0[3]));
                w.z = cvt_pk_bf16(silu_mul(g1[0], u1[0]), silu_mul(g1[1], u1[1])); w.w = cvt_pk_bf16(silu_mul(g1[2], u1[2]), silu_mul(g1[3], u1[3]));
                *(u32x4*)(O + (size_t)row * ldc + col0) = w;
            }
    }
};
struct EpiResid {
    static constexpr bool PERM = true, AFTER_DRAIN = false;
    const float* base; float* out; bf16_t* outb; float* ss; float coef;
    __device__ __forceinline__ void operator()(const f32x4 (&acc)[2][2][4][2], const Unit& u, int wr, int wc, int fr, int fq) const {
        const int row0 = u.pm * BM + wr * 64 + fr; const int col0 = u.pn * BM + wc * 32 + 8 * fq;
#pragma unroll
        for (int ai = 0; ai < 2; ++ai)
#pragma unroll
            for (int m = 0; m < 4; ++m) {
                const int row = row0 + ai * HALF + m * 16; float q = 0.f;
#pragma unroll
                for (int bj = 0; bj < 2; ++bj) {
                    const size_t off = (size_t)row * 1024 + col0 + bj * HALF;
                    const f32x4 b0 = *(const f32x4*)(base + off), b1 = *(const f32x4*)(base + off + 4);
                    const f32x4 v0 = b0 + acc[ai][bj][m][0] * coef, v1 = b1 + acc[ai][bj][m][1] * coef;
                    *(f32x4*)(out + off) = v0; *(f32x4*)(out + off + 4) = v1;
                    q += (v0[0] * v0[0] + v0[1] * v0[1]) + (v0[2] * v0[2] + v0[3] * v0[3]) + (v1[0] * v1[0] + v1[1] * v1[1]) + (v1[2] * v1[2] + v1[3] * v1[3]);
                    if (outb) { u32x4 w; w.x = cvt_pk_bf16(v0[0], v0[1]); w.y = cvt_pk_bf16(v0[2], v0[3]); w.z = cvt_pk_bf16(v1[0], v1[1]); w.w = cvt_pk_bf16(v1[2], v1[3]); *(u32x4*)(outb + off) = w; }
                }
                q += __shfl_xor(q, 16); q += __shfl_xor(q, 32);
                if (fq == 0) ss[(size_t)row * 16 + u.pn * 4 + wc] = q;
            }
    }
};
struct EpiIn {
    static constexpr bool PERM = true, AFTER_DRAIN = false;
    bf16_t *Q, *K, *VT, *PC; const float* ss; const float* rope;
    __device__ __forceinline__ void operator()(const f32x4 (&acc)[2][2][4][2], const Unit& u, int wr, int wc, int fr, int fq) const {
        const int row0 = u.pm * BM + wr * 64 + fr; const int cl = wc * 32 + 8 * fq; const int pn = u.pn;
        const bool dorope = ((wc & 1) == 0) && (fq < 2); const float sgn = (fq == 0) ? -1.f : 1.f;
        constexpr float QSCALE = 0.125f * 1.44269504089f;
#pragma unroll
        for (int ai = 0; ai < 2; ++ai)
#pragma unroll
            for (int m = 0; m < 4; ++m) {
                const int row = row0 + ai * HALF + m * 16; const float rs = row_rs(ss, row); const int pos = row & 4095;
                f32x4 c0 = {1.f, 1.f, 1.f, 1.f}, c1 = c0, s0 = {0.f, 0.f, 0.f, 0.f}, s1 = s0;
                if (pn <= 2) { const f32x4* rp = (const f32x4*)(rope + (size_t)pos * 16); c0 = rp[0]; c1 = rp[1]; s0 = rp[2]; s1 = rp[3]; }
#pragma unroll
                for (int bj = 0; bj < 2; ++bj) {
                    f32x4 v0 = acc[ai][bj][m][0] * rs, v1 = acc[ai][bj][m][1] * rs;
                    const bool isq = pn < 2, isk = (pn == 2 && bj == 0), isv = (pn == 2 && bj == 1);
                    if (isq || isk) {
                        f32x4 p0, p1;
#pragma unroll
                        for (int i = 0; i < 4; ++i) { p0[i] = __shfl_xor(v0[i], 16); p1[i] = __shfl_xor(v1[i], 16); }
                        const f32x4 r0 = v0 * c0 + p0 * s0 * sgn, r1 = v1 * c1 + p1 * s1 * sgn;
                        if (dorope) { v0 = r0; v1 = r1; }
                        if (isq) { v0 = v0 * QSCALE; v1 = v1 * QSCALE; }
                    }
                    u32x4 w; w.x = cvt_pk_bf16(v0[0], v0[1]); w.y = cvt_pk_bf16(v0[2], v0[3]); w.z = cvt_pk_bf16(v1[0], v1[1]); w.w = cvt_pk_bf16(v1[2], v1[3]);
                    if (isq) *(u32x4*)(Q + (size_t)row * 512 + pn * 256 + bj * HALF + cl) = w;
                    else if (isk) *(u32x4*)(K + (size_t)row * 128 + cl) = w;
                    else if (isv) {
                        const int kvh = wc >> 1, d0 = (wc & 1) * 32 + 8 * fq, b = row >> 12;
                        bf16_t* vp = VT + ((size_t)(b * 2 + kvh) * 64 + d0) * 4096 + pos;
                        vp[0 * 4096] = (bf16_t)(w.x & 0xffffu); vp[1 * 4096] = (bf16_t)(w.x >> 16); vp[2 * 4096] = (bf16_t)(w.y & 0xffffu); vp[3 * 4096] = (bf16_t)(w.y >> 16);
                        vp[4 * 4096] = (bf16_t)(w.z & 0xffffu); vp[5 * 4096] = (bf16_t)(w.z >> 16); vp[6 * 4096] = (bf16_t)(w.w & 0xffffu); vp[7 * 4096] = (bf16_t)(w.w >> 16);
                    } else *(u32x4*)(PC + (size_t)row * 512 + (pn - 3) * 256 + bj * HALF + cl) = w;
                }
            }
    }
};
template <class Epi, class Sched, bool ALIGN_EPI = false, bool SP2 = false>
__device__ __forceinline__ void gemm_phase(PG8_LAS unsigned char* lds, const Gemm g, const Sched& S, const Epi& E) {
    const int tid = threadIdx.x, wid = __builtin_amdgcn_readfirstlane(tid >> 6), lane = tid & 63, wr = wid >> 2, wc = wid & 3, fr = lane & 15, fq = lane >> 4;
    const int K = g.K, nt = K / BK;
    unsigned voffA[2], voffB[2];
#pragma unroll
    for (int i = 0; i < 2; ++i) { int R, C; stage_rc(tid * 16 + i * 8192, R, C); const int Rb = Epi::PERM ? ((R & ~31) + perm32(R & 31)) : R;
        voffA[i] = (unsigned)(R * K + C) * 2u; voffB[i] = (unsigned)(Rb * K + C) * 2u; }
    const size_t kstep = (size_t)(BK * 2);
    const size_t hstep = (size_t)HALF * K * 2;
    const size_t tstep = 2 * hstep;
    const unsigned ldsw = (unsigned)wid * 1024u;
    const int aoff = lds_byte(wr * 64 + fr, fq * 8), boff = lds_byte(wc * 32 + fr, fq * 8);
#define PG8_SA(b, h) (((b) * 2 + (h)) * HTB)
#define PG8_SB(b, h) ((4 + (b) * 2 + (h)) * HTB)
#define PG8_STAGE(bufoff, gbase, voff) do { _Pragma("unroll") for (int _i = 0; _i < 2; ++_i) \
        __builtin_amdgcn_global_load_lds((const unsigned*)((const char*)(gbase) + (voff)[_i]), (PG8_LAS unsigned*)(lds + (bufoff) + ldsw + _i * 8192), 16, 0, 0); } while (0)
#define PG8_LDA(dst, b, h) do { _Pragma("unroll") for (int m = 0; m < 4; ++m) _Pragma("unroll") for (int k = 0; k < 2; ++k) dst[m][k] = *(const PG8_LAS bf16x8*)(lds + PG8_SA(b, h) + aoff + m * 2048 + k * 1024); } while (0)
#define PG8_LDB(dst, b, h) do { _Pragma("unroll") for (int n = 0; n < 2; ++n) _Pragma("unroll") for (int k = 0; k < 2; ++k) dst[n][k] = *(const PG8_LAS bf16x8*)(lds + PG8_SB(b, h) + boff + n * 2048 + k * 1024); } while (0)
#define PG8_MMA(ai, bj, At, Bt) do { __builtin_amdgcn_s_setprio(1); _Pragma("unroll") for (int m = 0; m < 4; ++m) _Pragma("unroll") for (int n = 0; n < 2; ++n) _Pragma("unroll") for (int k = 0; k < 2; ++k) \
        acc[ai][bj][m][n] = __builtin_amdgcn_mfma_f32_16x16x32_bf16(Bt[n][k], At[m][k], acc[ai][bj][m][n], 0, 0, 0); __builtin_amdgcn_s_setprio(0); } while (0)
#define PG8_WAIT_V(n) asm volatile("s_waitcnt vmcnt(" #n ")" ::: "memory")
#define PG8_WAIT_L(n) asm volatile("s_waitcnt lgkmcnt(" #n ")" ::: "memory")
#define PG8_BAR __builtin_amdgcn_s_barrier()
#define PG8_SCHED __builtin_amdgcn_sched_barrier(0)
    Unit cur, nxt; int ui = 0;
    if (!S.next(0, cur)) return;
    f32x4 acc[2][2][4][2];
#pragma unroll
    for (int a = 0; a < 2; ++a)
#pragma unroll
        for (int b = 0; b < 2; ++b)
#pragma unroll
            for (int m = 0; m < 4; ++m)
#pragma unroll
                for (int n = 0; n < 2; ++n) acc[a][b][m][n] = (f32x4){0.f, 0.f, 0.f, 0.f};
    bf16x8 At[4][2], B0[2][2], B1[2][2];
    const char* cA = (const char*)g.A + (size_t)cur.pm * tstep; const char* cB = (const char*)g.Bt + (size_t)cur.pn * tstep;
    S.a_ready(cur);
    if constexpr (SP2) {
        PG8_STAGE(PG8_SB(0, 0), cB, voffB); PG8_STAGE(PG8_SB(0, 1), cB + hstep, voffB); PG8_STAGE(PG8_SA(0, 0), cA, voffA); PG8_STAGE(PG8_SA(0, 1), cA + hstep, voffA);
        if (wr == 1) PG8_BAR;
        PG8_WAIT_V(2); PG8_BAR;
        PG8_STAGE(PG8_SB(1, 0), cB + kstep, voffB); PG8_STAGE(PG8_SA(1, 0), cA + kstep, voffA); PG8_STAGE(PG8_SB(1, 1), cB + hstep + kstep, voffB);
        PG8_WAIT_V(6); PG8_BAR;
    } else {
        PG8_STAGE(PG8_SB(0, 0), cB, voffB); PG8_STAGE(PG8_SA(0, 0), cA, voffA); PG8_STAGE(PG8_SB(0, 1), cB + hstep, voffB); PG8_STAGE(PG8_SA(0, 1), cA + hstep, voffA);
        if (wr == 1) PG8_BAR;
        PG8_WAIT_V(4); PG8_BAR;
        PG8_STAGE(PG8_SB(1, 0), cB + kstep, voffB); PG8_STAGE(PG8_SA(1, 0), cA + kstep, voffA); PG8_STAGE(PG8_SB(1, 1), cB + hstep + kstep, voffB);
        PG8_WAIT_V(6); PG8_BAR;
    }
    for (;;) {
        const bool has_next = S.next(ui + 1, nxt);
        const char* nA = has_next ? (const char*)g.A + (size_t)nxt.pm * tstep : cA; const char* nB = has_next ? (const char*)g.Bt + (size_t)nxt.pn * tstep : cB;
        for (int t = 0; t < nt; t += 2) {
            const bool last = (t == nt - 2);
            const char* a1 = cA + (size_t)(t + 1) * kstep;
            const char* a2 = last ? nA : cA + (size_t)(t + 2) * kstep; const char* b2 = last ? nB : cB + (size_t)(t + 2) * kstep;
            const char* a3 = a2 + kstep; const char* b3 = b2 + kstep;
            if (last && has_next) S.a_ready(nxt);
            if constexpr (SP2) {
            PG8_LDB(B0, 0, 0); PG8_LDB(B1, 0, 1); PG8_SCHED; PG8_LDA(At, 0, 0); PG8_STAGE(PG8_SA(1, 1), a1 + hstep, voffA);
            PG8_WAIT_V(8); PG8_WAIT_L(0); PG8_BAR; PG8_MMA(0, 0, At, B0); PG8_MMA(0, 1, At, B1); PG8_BAR; PG8_SCHED;
            PG8_LDA(At, 0, 1); PG8_STAGE(PG8_SB(0, 0), b2, voffB); PG8_STAGE(PG8_SB(0, 1), b2 + hstep, voffB); PG8_STAGE(PG8_SA(0, 0), a2, voffA);
            PG8_WAIT_V(8); PG8_WAIT_L(0); PG8_BAR; PG8_MMA(1, 0, At, B0); PG8_MMA(1, 1, At, B1); PG8_BAR; PG8_SCHED;
            PG8_LDB(B0, 1, 0); PG8_LDB(B1, 1, 1); PG8_SCHED; PG8_LDA(At, 1, 0); PG8_STAGE(PG8_SA(0, 1), a2 + hstep, voffA);
            PG8_WAIT_V(8); PG8_WAIT_L(0); PG8_BAR; PG8_MMA(0, 0, At, B0); PG8_MMA(0, 1, At, B1); PG8_BAR; PG8_SCHED;
            PG8_LDA(At, 1, 1); PG8_STAGE(PG8_SB(1, 0), b3, voffB); PG8_STAGE(PG8_SB(1, 1), b3 + hstep, voffB); PG8_STAGE(PG8_SA(1, 0), a3, voffA);
            PG8_WAIT_V(8); PG8_WAIT_L(0); PG8_BAR; PG8_MMA(1, 0, At, B0); PG8_MMA(1, 1, At, B1); PG8_BAR; PG8_SCHED;
            } else {
            PG8_LDB(B0, 0, 0); PG8_SCHED; PG8_LDA(At, 0, 0); PG8_STAGE(PG8_SA(1, 1), a1 + hstep, voffA);
            PG8_WAIT_L(8); PG8_BAR; PG8_WAIT_L(0); PG8_MMA(0, 0, At, B0); PG8_BAR; PG8_SCHED;
            PG8_LDB(B1, 0, 1); PG8_STAGE(PG8_SB(0, 0), b2, voffB);
            PG8_BAR; PG8_WAIT_L(0); PG8_MMA(0, 1, At, B1); PG8_BAR;
            PG8_LDA(At, 0, 1); PG8_STAGE(PG8_SA(0, 0), a2, voffA);
            PG8_BAR; PG8_WAIT_L(0); PG8_MMA(1, 0, At, B0); PG8_BAR; PG8_SCHED;
            PG8_STAGE(PG8_SB(0, 1), b2 + hstep, voffB);
            PG8_WAIT_V(6); PG8_BAR; PG8_MMA(1, 1, At, B1); PG8_BAR;
            PG8_LDB(B0, 1, 0); PG8_SCHED; PG8_LDA(At, 1, 0); PG8_STAGE(PG8_SA(0, 1), a2 + hstep, voffA);
            PG8_WAIT_L(8); PG8_BAR; PG8_WAIT_L(0); PG8_MMA(0, 0, At, B0); PG8_BAR; PG8_SCHED;
            PG8_LDB(B1, 1, 1); PG8_STAGE(PG8_SB(1, 0), b3, voffB);
            PG8_BAR; PG8_WAIT_L(0); PG8_MMA(0, 1, At, B1); PG8_BAR;
            PG8_LDA(At, 1, 1); PG8_STAGE(PG8_SA(1, 0), a3, voffA);
            PG8_BAR; PG8_WAIT_L(0); PG8_MMA(1, 0, At, B0); PG8_BAR; PG8_SCHED;
            PG8_STAGE(PG8_SB(1, 1), b3 + hstep, voffB);
            PG8_WAIT_V(6); PG8_BAR; PG8_MMA(1, 1, At, B1); PG8_BAR;
            }
        }
        if constexpr (ALIGN_EPI) { if (wr == 0) PG8_BAR; }
        if constexpr (!Epi::AFTER_DRAIN) { E(acc, cur, wr, wc, fr, fq); S.done(cur); }
        if (!has_next) break;
#pragma unroll
        for (int a = 0; a < 2; ++a)
#pragma unroll
            for (int b = 0; b < 2; ++b)
#pragma unroll
                for (int m = 0; m < 4; ++m)
#pragma unroll
                    for (int n = 0; n < 2; ++n) acc[a][b][m][n] = (f32x4){0.f, 0.f, 0.f, 0.f};
        cur = nxt; cA = nA; cB = nB; ++ui;
        if constexpr (ALIGN_EPI) { if (wr == 1) PG8_BAR; }
    }
    PG8_WAIT_V(0);
    if constexpr (!ALIGN_EPI) { if (wr == 0) PG8_BAR; }
    PG8_BAR;
    if constexpr (Epi::AFTER_DRAIN) { E.fused(acc, cur, wr, wc, fr, fq, lds, wid, lane); S.done(cur); }
#undef PG8_SA
#undef PG8_SB
#undef PG8_STAGE
#undef PG8_LDA
#undef PG8_LDB
#undef PG8_MMA
#undef PG8_WAIT_V
#undef PG8_WAIT_L
#undef PG8_BAR
#undef PG8_SCHED
}
}
constexpr int NWAVES = 8, NTHR = NWAVES * 64;
constexpr int BATCH = 8, SEQ = 4096, DM = 1024, FF = 2816, M = BATCH * SEQ, INW = 1280, NGU = 2 * FF;
constexpr int N_PHASES = 9;
#ifndef MK_N_LAUNCHES
#define MK_N_LAUNCHES 1
#endif
constexpr size_t MiB = 1u << 20;
constexpr size_t WS_WGU1 = 0, WS_WD1 = 11 * MiB, WS_WGU2 = 17 * MiB, WS_WD2 = 28 * MiB, WS_WIN = 34 * MiB, WS_WOUT = 37 * MiB;
constexpr size_t WS_PWT = 39 * MiB, WS_ROPE = 39 * MiB + 512 * 1024, WS_SS0 = 40 * MiB, WS_SS1 = 42 * MiB, WS_SS2 = 44 * MiB, WS_SS3 = 46 * MiB;
constexpr size_t WS_A = 48 * MiB;
constexpr size_t WS_B = 112 * MiB;
constexpr size_t WS_HID = 176 * MiB;
constexpr size_t WS_Q = WS_HID, WS_K = WS_HID + 32 * MiB, WS_VT = WS_HID + 40 * MiB, WS_PC = WS_HID + 48 * MiB;
constexpr size_t WS_END = 352 * MiB;
static_assert(WS_WD1 >= (size_t)NGU * DM * 2 && WS_WGU2 - WS_WD1 >= (size_t)DM * FF * 2 && WS_WIN - WS_WD2 >= (size_t)DM * FF * 2 && WS_WOUT - WS_WIN >= (size_t)INW * DM * 2, "ws map");
constexpr int LDS_BYTES = 147456;

#define GAS __attribute__((address_space(1)))
#define LAS __attribute__((address_space(3)))
typedef unsigned short bf16;
typedef unsigned v4u __attribute__((ext_vector_type(4)));
typedef unsigned v2u __attribute__((ext_vector_type(2)));
typedef float f32x4 __attribute__((ext_vector_type(4)));
typedef float f32x16 __attribute__((ext_vector_type(16)));
typedef short bf16x8 __attribute__((ext_vector_type(8)));
#define LDS_WAIT() asm volatile("s_waitcnt lgkmcnt(0)" ::: "memory")
__device__ __forceinline__ unsigned pk2(float lo, float hi) { return pg8::cvt_pk_bf16(lo, hi); }
__device__ __forceinline__ float bf_lo(unsigned w) { return __uint_as_float(w << 16); }
__device__ __forceinline__ float bf_hi(unsigned w) { return __uint_as_float(w & 0xffff0000u); }
__device__ __forceinline__ float wave_sum(float v) {
#pragma unroll
    for (int o = 1; o < 64; o <<= 1) v += __shfl_xor(v, o);
    return v;
}

__device__ __forceinline__ void transpose_item(const float* W, int ldw, int n0, int k0, bf16* WT, int ldt, int r0, const float* gain, LAS float* scr, int lane) {
#pragma unroll 8
    for (int i = 0; i < 32; ++i) { const int kk = 2 * i + (lane >> 5); float v = W[(size_t)(k0 + kk) * ldw + n0 + (lane & 31)]; if (gain) v *= gain[k0 + kk]; scr[kk * 33 + (lane & 31)] = v; }
    LDS_WAIT(); asm volatile("" ::: "memory");
    const int c = lane & 7;
#pragma unroll
    for (int j = 0; j < 4; ++j) { const int n = (lane >> 3) + 8 * j; const LAS float* s = scr + (8 * c) * 33 + n;
        v4u o; o.x = pk2(s[0 * 33], s[1 * 33]); o.y = pk2(s[2 * 33], s[3 * 33]); o.z = pk2(s[4 * 33], s[5 * 33]); o.w = pk2(s[6 * 33], s[7 * 33]);
        *(v4u*)(WT + (size_t)(r0 + n) * ldt + k0 + 8 * c) = o; }
    LDS_WAIT(); asm volatile("" ::: "memory");
}
__device__ __forceinline__ void gu_item(const float* Wg, const float* Wu, const float* gain, bf16* WT, int r, LAS float* scr, int lane) {
    const int kb = r / 176, nb = r % 176, pn = nb >> 3, bj = (nb >> 2) & 1, j0 = (nb & 3) * 32;
    transpose_item(bj ? Wu : Wg, FF, 128 * pn + j0, kb * 64, WT, DM, nb * 32, gain, scr, lane);
}
struct Ptrs {
    const float *x, *g1, *Wg1, *Wu1, *Wd1, *gm, *Win, *sink, *pw, *pscale, *Wout, *g2, *Wg2, *Wu2, *Wd2, *gf;
    float* out;
    bf16 *WGU1, *WD1, *WGU2, *WD2, *WIN, *WOUT, *PWT, *XA, *HB, *HID, *Q, *K, *VT, *PC;
    float *ROPE, *SS0, *SS1, *SS2, *SS3;
};
__device__ __forceinline__ void p0_prologue(const Ptrs& P, LAS unsigned char* lds, int gw, int NGW, int wave, int lane) {
    LAS float* scr = (LAS float*)(lds + wave * 16384);
    constexpr int I_GU = 16 * 176, I_D = 44 * 32, I_IN = 16 * 40, I_OUT = 16 * 32, I_PW = 32;
    constexpr int NITEMS = 2 * I_GU + 2 * I_D + I_IN + I_OUT + I_PW;
    for (int it = gw; it < NITEMS; it += NGW) {
        int r = it;
        if (r < I_GU) { gu_item(P.Wg1, P.Wu1, P.g1, P.WGU1, r, scr, lane); continue; } r -= I_GU;
        if (r < I_GU) { gu_item(P.Wg2, P.Wu2, P.g2, P.WGU2, r, scr, lane); continue; } r -= I_GU;
        if (r < I_D) { transpose_item(P.Wd1, DM, (r & 31) * 32, (r >> 5) * 64, P.WD1, FF, (r & 31) * 32, nullptr, scr, lane); continue; } r -= I_D;
        if (r < I_D) { transpose_item(P.Wd2, DM, (r & 31) * 32, (r >> 5) * 64, P.WD2, FF, (r & 31) * 32, nullptr, scr, lane); continue; } r -= I_D;
        if (r < I_IN) { const int kb = r / 40, nb = r % 40; transpose_item(P.Win, INW, nb * 32, kb * 64, P.WIN, DM, nb * 32, P.gm, scr, lane); continue; } r -= I_IN;
        if (r < I_OUT) { transpose_item(P.Wout, DM, (r & 31) * 32, (r >> 5) * 64, P.WOUT, DM, (r & 31) * 32, nullptr, scr, lane); continue; } r -= I_OUT;
        { const int g = r >> 3, kb = (r >> 2) & 1, nb = r & 3; transpose_item(P.pw + (size_t)g * 16384, 128, nb * 32, kb * 64, P.PWT + (size_t)g * 16384, 128, nb * 32, nullptr, scr, lane); }
    }
    for (int m = gw; m < M; m += NGW) {
        const f32x4* xr = (const f32x4*)(P.x + (size_t)m * DM) + lane;
        f32x4 v[4]; float s = 0.f;
#pragma unroll
        for (int j = 0; j < 4; ++j) { v[j] = xr[64 * j]; s += (v[j][0] * v[j][0] + v[j][1] * v[j][1]) + (v[j][2] * v[j][2] + v[j][3] * v[j][3]); }
        const float tot = wave_sum(s);
        v2u* o8 = (v2u*)(P.XA + (size_t)m * DM) + lane;
#pragma unroll
        for (int j = 0; j < 4; ++j) { v2u w; w.x = pk2(v[j][0], v[j][1]); w.y = pk2(v[j][2], v[j][3]); o8[64 * j] = w; }
        if (lane < 4) ((f32x4*)(P.SS0 + (size_t)m * 16))[lane] = (f32x4){lane == 0 ? tot : 0.f, 0.f, 0.f, 0.f};
    }
    for (int i = gw * 64 + lane; i < SEQ * 8; i += NGW * 64) {
        const int pos = i >> 3, j = i & 7;
        const float inv = powf(500000.0f, -(float)j * 0.125f);
        const float ang = (float)pos * inv;
        const double a = (double)ang; const double kq = rint(a * 0.63661977236758134308);
        const double y = a - kq * 1.57079632679489661923; const double y2 = y * y;
        const double sy = y * (1.0 + y2 * (-1.0 / 6 + y2 * (1.0 / 120 + y2 * (-1.0 / 5040 + y2 * (1.0 / 362880 - y2 * (1.0 / 39916800))))));
        const double cy = 1.0 + y2 * (-0.5 + y2 * (1.0 / 24 + y2 * (-1.0 / 720 + y2 * (1.0 / 40320 + y2 * (-1.0 / 3628800 + y2 * (1.0 / 479001600))))));
        const int k4 = ((int)kq) & 3;
        const double cs = (k4 == 0) ? cy : (k4 == 1) ? -sy : (k4 == 2) ? -cy : sy;
        const double sn = (k4 == 0) ? sy : (k4 == 1) ? cy : (k4 == 2) ? -sy : -cy;
        P.ROPE[pos * 16 + j] = (float)cs; P.ROPE[pos * 16 + 8 + j] = (float)sn;
    }
}

__device__ __forceinline__ void attn_item(const Ptrs& P, int b, int kvh, int n, int g, int half, int lane) {
    const int ql = lane & 31, hi = lane >> 5, head = kvh * 4 + g, q0 = n * 128 + half * 64;
    const size_t rowbase = (size_t)b * SEQ;
    bf16x8 Qf[2][4];
#pragma unroll
    for (int qb = 0; qb < 2; ++qb)
#pragma unroll
        for (int ks = 0; ks < 4; ++ks) Qf[qb][ks] = *(const bf16x8*)(P.Q + (rowbase + q0 + 32 * qb + ql) * 512 + head * 64 + 16 * ks + 8 * hi);
    f32x16 O[2][2];
#pragma unroll
    for (int db = 0; db < 2; ++db)
#pragma unroll
        for (int qb = 0; qb < 2; ++qb)
#pragma unroll
            for (int v = 0; v < 16; ++v) O[db][qb][v] = 0.f;
    const float sk = P.sink[head] * 1.44269504089f;
    float mrun[2] = {sk, sk}, lrun[2] = {hi == 0 ? 1.f : 0.f, hi == 0 ? 1.f : 0.f};
    const int pr = 16 * (ql >> 4) + 8 * ((ql >> 2) & 1) + (ql & 3) + 4 * ((ql >> 3) & 1);
    const int t0 = q0 >> 5; const int kt_lo = (t0 - 4) < 0 ? 0 : (t0 - 4), kt_hi = (t0 + 5) > 127 ? 127 : (t0 + 5);
    const bf16* Kp = P.K + rowbase * 128 + kvh * 64 + 8 * hi;
    const bf16* Vp = P.VT + ((size_t)(b * 2 + kvh) * 64 + ql) * SEQ + 8 * hi;
    for (int kt = kt_lo; kt <= kt_hi; ++kt) {
        const int kbase = kt * 32;
        bf16x8 Kf[4], Vf[2][2];
#pragma unroll
        for (int ks = 0; ks < 4; ++ks) Kf[ks] = *(const bf16x8*)(Kp + (size_t)(kbase + pr) * 128 + 16 * ks);
#pragma unroll
        for (int db = 0; db < 2; ++db)
#pragma unroll
            for (int t = 0; t < 2; ++t) Vf[db][t] = *(const bf16x8*)(Vp + (size_t)db * 32 * SEQ + kbase + 16 * t);
        f32x16 S[2];
#pragma unroll
        for (int qb = 0; qb < 2; ++qb) {
#pragma unroll
            for (int v = 0; v < 16; ++v) S[qb][v] = 0.f;
#pragma unroll
            for (int ks = 0; ks < 4; ++ks) S[qb] = __builtin_amdgcn_mfma_f32_32x32x16_bf16(Kf[ks], Qf[qb][ks], S[qb], 0, 0, 0);
        }
        const bool edge = (kbase < q0 - 64) || (kbase > q0 + 96);
        if (edge) {
#pragma unroll
            for (int qb = 0; qb < 2; ++qb) { const int q = q0 + 32 * qb + ql;
#pragma unroll
                for (int v = 0; v < 16; ++v) { const int kk = kbase + 16 * (v >> 3) + 8 * hi + (v & 7); const int dd = q - kk; if (dd > 128 || dd < -128) S[qb][v] = -1e30f; } }
        }
        bf16x8 Pb[2][2];
#pragma unroll
        for (int qb = 0; qb < 2; ++qb) {
            float mt = S[qb][0];
#pragma unroll
            for (int v = 1; v < 16; ++v) mt = fmaxf(mt, S[qb][v]);
            mt = fmaxf(mt, __shfl_xor(mt, 32));
            const float mn = fmaxf(mrun[qb], mt); const float alpha = __builtin_amdgcn_exp2f(mrun[qb] - mn); mrun[qb] = mn;
            float ps = 0.f;
#pragma unroll
            for (int v = 0; v < 16; ++v) { const float p = __builtin_amdgcn_exp2f(S[qb][v] - mn); S[qb][v] = p; ps += p; }
            lrun[qb] = lrun[qb] * alpha + ps;
#pragma unroll
            for (int db = 0; db < 2; ++db)
#pragma unroll
                for (int v = 0; v < 16; ++v) O[db][qb][v] *= alpha;
#pragma unroll
            for (int t = 0; t < 2; ++t) { v4u w; w.x = pk2(S[qb][8 * t + 0], S[qb][8 * t + 1]); w.y = pk2(S[qb][8 * t + 2], S[qb][8 * t + 3]); w.z = pk2(S[qb][8 * t + 4], S[qb][8 * t + 5]); w.w = pk2(S[qb][8 * t + 6], S[qb][8 * t + 7]);
                Pb[qb][t] = __builtin_bit_cast(bf16x8, w); }
        }
#pragma unroll
        for (int db = 0; db < 2; ++db)
#pragma unroll
            for (int qb = 0; qb < 2; ++qb)
#pragma unroll
                for (int t = 0; t < 2; ++t) O[db][qb] = __builtin_amdgcn_mfma_f32_32x32x16_bf16(Vf[db][t], Pb[qb][t], O[db][qb], 0, 0, 0);
    }
#pragma unroll
    for (int qb = 0; qb < 2; ++qb) {
        const float lt = lrun[qb] + __shfl_xor(lrun[qb], 32); const float inv = 1.0f / lt;
        bf16* op = P.XA + (rowbase + q0 + 32 * qb + ql) * 1024 + head * 64 + 4 * hi;
#pragma unroll
        for (int db = 0; db < 2; ++db)
#pragma unroll
            for (int c = 0; c < 4; ++c) { v2u w; w.x = pk2(O[db][qb][4 * c + 0] * inv, O[db][qb][4 * c + 1] * inv); w.y = pk2(O[db][qb][4 * c + 2] * inv, O[db][qb][4 * c + 3] * inv);
                *(v2u*)(op + 32 * db + 8 * c) = w; }
    }
}
__device__ __forceinline__ void pool_item(const Ptrs& P, int tile, int g, int lane) {
    const int tl = lane & 31, hi = lane >> 5, t = tile * 32 + tl, s = t & (SEQ - 1), half = 1 << g;
    const int a1 = (s - half) < 0 ? 0 : (s - half), b1 = (s + half) > SEQ ? SEQ : (s + half);
    const int a2 = (s - half + 1) < 0 ? 0 : (s - half + 1), b2 = (s + half + 1) > SEQ ? SEQ : (s + half + 1);
    const float w1 = 0.5f / (float)(b1 - a1), w2 = 0.5f / (float)(b2 - a2);
    float acc[8][8];
#pragma unroll
    for (int ks = 0; ks < 8; ++ks)
#pragma unroll
        for (int e = 0; e < 8; ++e) acc[ks][e] = 0.f;
    const bf16* base = P.PC + (size_t)t * 512 + g * 128 + 8 * hi;
    for (int dl = -half; dl <= half; ++dl) {
        const int sp = s + dl; const bool valid = (sp >= 0) && (sp < SEQ);
        float w = (dl == -half) ? w1 : ((dl == half) ? w2 : (w1 + w2));
        if (!valid) w = 0.f;
        if (dl == 0) w -= 1.f;
        const bf16* p = base + (valid ? dl : 0) * 512;
#pragma unroll
        for (int ks = 0; ks < 8; ++ks) { const v4u raw = *(const v4u*)(p + 16 * ks);
            acc[ks][0] += w * bf_lo(raw.x); acc[ks][1] += w * bf_hi(raw.x); acc[ks][2] += w * bf_lo(raw.y); acc[ks][3] += w * bf_hi(raw.y);
            acc[ks][4] += w * bf_lo(raw.z); acc[ks][5] += w * bf_hi(raw.z); acc[ks][6] += w * bf_lo(raw.w); acc[ks][7] += w * bf_hi(raw.w); }
    }
    bf16x8 df[8];
#pragma unroll
    for (int ks = 0; ks < 8; ++ks) { v4u w; w.x = pk2(acc[ks][0], acc[ks][1]); w.y = pk2(acc[ks][2], acc[ks][3]); w.z = pk2(acc[ks][4], acc[ks][5]); w.w = pk2(acc[ks][6], acc[ks][7]); df[ks] = __builtin_bit_cast(bf16x8, w); }
    bf16* op = P.XA + (size_t)t * 1024 + 512 + g * 128 + 4 * hi;
    const float* scp = P.pscale + g * 128 + 4 * hi;
#pragma unroll
    for (int nb = 0; nb < 4; ++nb) {
        f32x16 o;
#pragma unroll
        for (int v = 0; v < 16; ++v) o[v] = 0.f;
#pragma unroll
        for (int ks = 0; ks < 8; ++ks) { const bf16x8 wf = *(const bf16x8*)(P.PWT + ((size_t)(g * 128 + 32 * nb + tl)) * 128 + 16 * ks + 8 * hi); o = __builtin_amdgcn_mfma_f32_32x32x16_bf16(wf, df[ks], o, 0, 0, 0); }
#pragma unroll
        for (int c = 0; c < 4; ++c) { const f32x4 sc = *(const f32x4*)(scp + 32 * nb + 8 * c);
            v2u w; w.x = pk2(o[4 * c + 0] * sc[0], o[4 * c + 1] * sc[1]); w.y = pk2(o[4 * c + 2] * sc[2], o[4 * c + 3] * sc[3]); *(v2u*)(op + 32 * nb + 8 * c) = w; }
    }
}

struct Args { const float* in[16]; float* out; unsigned char* ws; int ph_lo, ph_hi; };
__global__ void __launch_bounds__(NTHR, 2) fwd_mega(Args args) {
    extern __shared__ __attribute__((aligned(16))) unsigned char lds_raw[];
    LAS unsigned char* lds = (LAS unsigned char*)lds_raw;
    cg::grid_group grid = cg::this_grid();
    const int tid = threadIdx.x, lane = tid & 63, wave = __builtin_amdgcn_readfirstlane(tid >> 6);
    const int G = gridDim.x, bx = blockIdx.x;
    const int gw = bx * NWAVES + wave, NGW = G * NWAVES;
    unsigned char* ws = args.ws;
    Ptrs P;
    P.x = args.in[0]; P.g1 = args.in[1]; P.Wg1 = args.in[2]; P.Wu1 = args.in[3]; P.Wd1 = args.in[4]; P.gm = args.in[5]; P.Win = args.in[6]; P.sink = args.in[7];
    P.pw = args.in[8]; P.pscale = args.in[9]; P.Wout = args.in[10]; P.g2 = args.in[11]; P.Wg2 = args.in[12]; P.Wu2 = args.in[13]; P.Wd2 = args.in[14]; P.gf = args.in[15];
    P.out = args.out;
    P.WGU1 = (bf16*)(ws + WS_WGU1); P.WD1 = (bf16*)(ws + WS_WD1); P.WGU2 = (bf16*)(ws + WS_WGU2); P.WD2 = (bf16*)(ws + WS_WD2); P.WIN = (bf16*)(ws + WS_WIN); P.WOUT = (bf16*)(ws + WS_WOUT);
    P.PWT = (bf16*)(ws + WS_PWT); P.XA = (bf16*)(ws + WS_A); P.HB = (bf16*)(ws + WS_B); P.HID = (bf16*)(ws + WS_HID);
    P.Q = (bf16*)(ws + WS_Q); P.K = (bf16*)(ws + WS_K); P.VT = (bf16*)(ws + WS_VT); P.PC = (bf16*)(ws + WS_PC);
    P.ROPE = (float*)(ws + WS_ROPE); P.SS0 = (float*)(ws + WS_SS0); P.SS1 = (float*)(ws + WS_SS1); P.SS2 = (float*)(ws + WS_SS2); P.SS3 = (float*)(ws + WS_SS3);
    const int lo = args.ph_lo, hi = args.ph_hi;
#define IN(k) (lo <= (k) && (k) < hi)
#define SEAM(k) do { if (IN(k) && IN((k) + 1)) grid.sync(); } while (0)

    if (IN(0)) { p0_prologue(P, lds, gw, NGW, wave, lane); SEAM(0); }
    if (IN(1)) {
        pg8::Gemm g{P.XA, P.WGU1, M, NGU, DM}; pg8::StaticOrder S; S.init(M, NGU, G, bx);
        pg8::EpiSwiglu E{P.HID, FF, P.SS0};
        pg8::gemm_phase<pg8::EpiSwiglu, pg8::StaticOrder, true, true>(lds, g, S, E);
        SEAM(1);
    }
    if (IN(2)) {
        pg8::Gemm g{P.HID, P.WD1, M, DM, FF}; pg8::StaticOrder S; S.init(M, DM, G, bx);
        pg8::EpiResid E{P.x, P.out, P.HB, P.SS1, 0.5f};
        pg8::gemm_phase<pg8::EpiResid, pg8::StaticOrder, true, true>(lds, g, S, E);
        SEAM(2);
    }
    if (IN(3)) {
        pg8::Gemm g{P.HB, P.WIN, M, INW, DM}; pg8::StaticOrder S; S.init(M, INW, G, bx);
        pg8::EpiIn E{P.Q, P.K, P.VT, P.PC, P.SS1, P.ROPE};
        pg8::gemm_phase<pg8::EpiIn, pg8::StaticOrder, true, true>(lds, g, S, E);
        SEAM(3);
    }
    if (IN(4)) {
        for (int u = bx; u < BATCH * 2 * 32; u += G) { const int n = u & 31, kvh = (u >> 5) & 1, b = u >> 6; attn_item(P, b, kvh, n, wave >> 1, wave & 1, lane); }
        for (int it = gw; it < 2048; it += NGW) { const int tile = it & 1023, g = it >> 10; pool_item(P, tile, g, lane); pool_item(P, tile, 3 - g, lane); }
        SEAM(4);
    }
    if (IN(5)) {
        pg8::Gemm g{P.XA, P.WOUT, M, DM, DM}; pg8::StaticOrder S; S.init(M, DM, G, bx);
        pg8::EpiResid E{P.out, P.out, P.HB, P.SS2, 1.0f};
        pg8::gemm_phase<pg8::EpiResid, pg8::StaticOrder, true, true>(lds, g, S, E);
        SEAM(5);
    }
    if (IN(6)) {
        pg8::Gemm g{P.HB, P.WGU2, M, NGU, DM}; pg8::StaticOrder S; S.init(M, NGU, G, bx);
        pg8::EpiSwiglu E{P.HID, FF, P.SS2};
        pg8::gemm_phase<pg8::EpiSwiglu, pg8::StaticOrder, true, true>(lds, g, S, E);
        SEAM(6);
    }
    if (IN(7)) {
        pg8::Gemm g{P.HID, P.WD2, M, DM, FF}; pg8::StaticOrder S; S.init(M, DM, G, bx);
        pg8::EpiResid E{P.out, P.out, nullptr, P.SS3, 0.5f};
        pg8::gemm_phase<pg8::EpiResid, pg8::StaticOrder, true, true>(lds, g, S, E);
        SEAM(7);
    }
    if (IN(8)) {
        for (int m = gw; m < M; m += NGW) {
            float q = P.SS3[(size_t)m * 16 + (lane & 15)];
            q += __shfl_xor(q, 1); q += __shfl_xor(q, 2); q += __shfl_xor(q, 4); q += __shfl_xor(q, 8);
            const float rs = 1.0f / sqrtf(q * (1.0f / 1024.0f) + pg8::RMS_EPS);
            f32x4* xr = (f32x4*)(P.out + (size_t)m * DM) + lane; const f32x4* gr = (const f32x4*)P.gf + lane;
#pragma unroll
            for (int j = 0; j < 4; ++j) { const f32x4 v = xr[64 * j]; xr[64 * j] = v * rs * gr[64 * j]; }
        }
    }
#undef IN
#undef SEAM
}

extern "C" void kernel_launch(void* const* d_in, const int* in_sizes, int n_in, void* d_out, int out_size, void* d_ws, size_t ws_size, hipStream_t stream) {
    static int grid = 0;
    if (grid == 0) {
        if (n_in != 16 || in_sizes[0] != M * DM || out_size != M * DM || ws_size < WS_END) { fprintf(stderr, "kernel_launch: unexpected shapes (n_in %d, in0 %d, out %d, ws %zu); nothing launched\n", n_in, n_in > 0 ? in_sizes[0] : -1, out_size, ws_size); grid = -1; return; }
        int dev = 0, cus = 0, per_cu = 0;
        if (hipGetDevice(&dev) != hipSuccess || hipDeviceGetAttribute(&cus, hipDeviceAttributeMultiprocessorCount, dev) != hipSuccess) { grid = -1; return; }
        if (hipFuncSetAttribute((const void*)fwd_mega, hipFuncAttributeMaxDynamicSharedMemorySize, LDS_BYTES) != hipSuccess) { fprintf(stderr, "kernel_launch: hipFuncSetAttribute failed\n"); grid = -1; return; }
        if (hipOccupancyMaxActiveBlocksPerMultiprocessor(&per_cu, (const void*)fwd_mega, NTHR, LDS_BYTES) != hipSuccess || per_cu < 1) { fprintf(stderr, "kernel_launch: occupancy query says %d blocks per CU\n", per_cu); (void)hipGetLastError(); grid = -1; return; }
        grid = cus * per_cu;
    }
    if (grid < 0) return;
    Args a{};
    for (int i = 0; i < 16; ++i) a.in[i] = (const float*)d_in[i];
    a.out = (float*)d_out; a.ws = (unsigned char*)d_ws;
#if MK_N_LAUNCHES == 1
    a.ph_lo = 0; a.ph_hi = N_PHASES;
    void* kargs[] = {&a};
    hipError_t e = hipLaunchCooperativeKernel((const void*)fwd_mega, dim3(grid), dim3(NTHR), kargs, LDS_BYTES, stream);
    if (e != hipSuccess) fprintf(stderr, "kernel_launch: cooperative launch failed: %s (grid %d)\n", hipGetErrorString(e), grid);
#else
    for (int p = 0; p < N_PHASES; ++p) { a.ph_lo = p; a.ph_hi = p + 1; hipLaunchKernelGGL(fwd_mega, dim3(grid), dim3(NTHR), LDS_BYTES, stream, a); }
#endif
}
```

```cpp
#include <hip/hip_runtime.h>
#include <hip/hip_cooperative_groups.h>
#include <cstdio>
#include <cstdint>
namespace cg = cooperative_groups;
namespace pg8 {
#define PG8_LAS __attribute__((address_space(3)))
typedef unsigned short bf16_t;
typedef short bf16x8 __attribute__((ext_vector_type(8)));
typedef float f32x4 __attribute__((ext_vector_type(4)));
typedef unsigned u32x4 __attribute__((ext_vector_type(4)));
constexpr int BM = 256, BK = 64, HALF = 128, HTB = HALF * BK * 2  , STAGE_BYTES = 8 * HTB, NXCD = 8, WGM = 8;

__host__ __device__ __forceinline__ int lds_byte(int r, int c) { const int st = (r >> 4) * 2 + (c >> 5), rr = r & 15, cc = c & 31, ob = rr * 64 + cc * 2; return st * 1024 + (ob ^ (((ob >> 9) & 1) << 5)); }
__host__ __device__ __forceinline__ void stage_rc(int b, int& R, int& C) { const int st = b / 1024, sb = b % 1024, swz = sb ^ (((sb >> 9) & 1) << 5); R = (st >> 1) * 16 + swz / 64; C = (st & 1) * 32 + (swz % 64) / 2; }
__host__ __device__ __forceinline__ int perm32(int rho) { const int n = rho >> 4, i = rho & 15; return 8 * (i >> 2) + 4 * n + (i & 3); }

struct Unit { int pm, pn; };
struct Gemm { const bf16_t* A; const bf16_t* Bt; int M, N, K; };

struct StaticOrder {
    int nM, nN, nwg, G, c;
    __host__ __device__ void init(int M, int N, int G_, int c_) { nM = M / BM; nN = N / BM; nwg = nM * nN; G = G_; c = c_; }
    __host__ __device__ bool next(int i, Unit& u) const {
        const long L = (long)i * G + c; if (L >= nwg) return false;
        int wgid = (int)L; { const int q = nwg / NXCD, r = nwg % NXCD, xcd = wgid % NXCD, off = wgid / NXCD; wgid = (xcd < r ? xcd * (q + 1) : r * (q + 1) + (xcd - r) * q) + off; }
        const int nig = WGM * nN, gid = wgid / nig, fm = gid * WGM, gsz = (nM - fm) < WGM ? (nM - fm) : WGM;
        u.pm = fm + ((wgid % nig) % gsz); u.pn = (wgid % nig) / gsz; return true;
    }
    __device__ __forceinline__ void a_ready(const Unit&) const {}
    __device__ __forceinline__ void done(const Unit&) const {}
};

__device__ __forceinline__ unsigned cvt_pk_bf16(float lo, float hi) { unsigned r; asm volatile("v_cvt_pk_bf16_f32 %0, %1, %2" : "=v"(r) : "v"(lo), "v"(hi)); return r; }
constexpr float RMS_EPS = 1e-6f;
__device__ __forceinline__ float row_rs(const float* ss, int row) {
    const f32x4* p = (const f32x4*)(ss + (size_t)row * 16);
    const f32x4 a = p[0], b = p[1], c = p[2], d = p[3];
    const f32x4 s = (a + b) + (c + d);
    const float t = (s[0] + s[1]) + (s[2] + s[3]);
    return 1.0f / sqrtf(t * (1.0f / 1024.0f) + RMS_EPS);
}
__device__ __forceinline__ float silu_mul(float g, float u) {
    const float e = __builtin_amdgcn_exp2f(g * -1.44269504089f);
    return g * __builtin_amdgcn_rcpf(1.0f + e) * u;
}
struct EpiSwiglu {
    static constexpr bool PERM = true, AFTER_DRAIN = false;
    bf16_t* O; int ldc; const float* ss;
    __device__ __forceinline__ void operator()(const f32x4 (&acc)[2][2][4][2], const Unit& u, int wr, int wc, int fr, int fq) const {
        const int row0 = u.pm * BM + wr * 64 + fr; const int col0 = u.pn * HALF + wc * 32 + 8 * fq;
#pragma unroll
        for (int ai = 0; ai < 2; ++ai)
#pragma unroll
            for (int m = 0; m < 4; ++m) {
                const int row = row0 + ai * HALF + m * 16; const float rs = row_rs(ss, row);
                const f32x4 g0 = acc[ai][0][m][0] * rs, g1 = acc[ai][0][m][1] * rs, u0 = acc[ai][1][m][0] * rs, u1 = acc[ai][1][m][1] * rs;
                u32x4 w;
                w.x = cvt_pk_bf16(silu_mul(g0[0], u0[0]), silu_mul(g0[1], u0[1])); w.y = cvt_pk_bf16(silu_mul(g0[2], u0[2]), silu_mul(g0[3], u0[3]));
                w.z = cvt_pk_bf16(silu_mul(g1[0], u1[0]), silu_mul(g1[1], u1[1])); w.w = cvt_pk_bf16(silu_mul(g1[2], u1[2]), silu_mul(g1[3], u1[3]));
                *(u32x4*)(O + (size_t)row * ldc + col0) = w;
            }
    }
};
struct EpiResid {
    static constexpr bool PERM = true, AFTER_DRAIN = false;
    const float* base; float* out; bf16_t* outb; float* ss; float coef;
    __device__ __forceinline__ void operator()(const f32x4 (&acc)[2][2][4][2], const Unit& u, int wr, int wc, int fr, int fq) const {
        const int row0 = u.pm * BM + wr * 64 + fr; const int col0 = u.pn * BM + wc * 32 + 8 * fq;
#pragma unroll
        for (int ai = 0; ai < 2; ++ai)
#pragma unroll
            for (int m = 0; m < 4; ++m) {
                const int row = row0 + ai * HALF + m * 16; float q = 0.f;
#pragma unroll
                for (int bj = 0; bj < 2; ++bj) {
                    const size_t off = (size_t)row * 1024 + col0 + bj * HALF;
                    const f32x4 b0 = *(const f32x4*)(base + off), b1 = *(const f32x4*)(base + off + 4);
                    const f32x4 v0 = b0 + acc[ai][bj][m][0] * coef, v1 = b1 + acc[ai][bj][m][1] * coef;
                    *(f32x4*)(out + off) = v0; *(f32x4*)(out + off + 4) = v1;
                    q += (v0[0] * v0[0] + v0[1] * v0[1]) + (v0[2] * v0[2] + v0[3] * v0[3]) + (v1[0] * v1[0] + v1[1] * v1[1]) + (v1[2] * v1[2] + v1[3] * v1[3]);
                    if (outb) { u32x4 w; w.x = cvt_pk_bf16(v0[0], v0[1]); w.y = cvt_pk_bf16(v0[2], v0[3]); w.z = cvt_pk_bf16(v1[0], v1[1]); w.w = cvt_pk_bf16(v1[2], v1[3]); *(u32x4*)(outb + off) = w; }
                }
                q += __shfl_xor(q, 16); q += __shfl_xor(q, 32);
                if (fq == 0) ss[(size_t)row * 16 + u.pn * 4 + wc] = q;
            }
    }
};
struct EpiIn {
    static constexpr bool PERM = true, AFTER_DRAIN = false;
    bf16_t *Q, *K, *VT, *PC; const float* ss; const float* rope;
    __device__ __forceinline__ void operator()(const f32x4 (&acc)[2][2][4][2], const Unit& u, int wr, int wc, int fr, int fq) const {
        const int row0 = u.pm * BM + wr * 64 + fr; const int cl = wc * 32 + 8 * fq; const int pn = u.pn;
        const bool dorope = ((wc & 1) == 0) && (fq < 2); const float sgn = (fq == 0) ? -1.f : 1.f;
        constexpr float QSCALE = 0.125f * 1.44269504089f;
#pragma unroll
        for (int ai = 0; ai < 2; ++ai)
#pragma unroll
            for (int m = 0; m < 4; ++m) {
                const int row = row0 + ai * HALF + m * 16; const float rs = row_rs(ss, row); const int pos = row & 4095;
                f32x4 c0 = {1.f, 1.f, 1.f, 1.f}, c1 = c0, s0 = {0.f, 0.f, 0.f, 0.f}, s1 = s0;
                if (pn <= 2) { const f32x4* rp = (const f32x4*)(rope + (size_t)pos * 16); c0 = rp[0]; c1 = rp[1]; s0 = rp[2]; s1 = rp[3]; }
#pragma unroll
                for (int bj = 0; bj < 2; ++bj) {
                    f32x4 v0 = acc[ai][bj][m][0] * rs, v1 = acc[ai][bj][m][1] * rs;
                    const bool isq = pn < 2, isk = (pn == 2 && bj == 0), isv = (pn == 2 && bj == 1);
                    if (isq || isk) {
                        f32x4 p0, p1;
#pragma unroll
                        for (int i = 0; i < 4; ++i) { p0[i] = __shfl_xor(v0[i], 16); p1[i] = __shfl_xor(v1[i], 16); }
                        const f32x4 r0 = v0 * c0 + p0 * s0 * sgn, r1 = v1 * c1 + p1 * s1 * sgn;
                        if (dorope) { v0 = r0; v1 = r1; }
                        if (isq) { v0 = v0 * QSCALE; v1 = v1 * QSCALE; }
                    }
                    u32x4 w; w.x = cvt_pk_bf16(v0[0], v0[1]); w.y = cvt_pk_bf16(v0[2], v0[3]); w.z = cvt_pk_bf16(v1[0], v1[1]); w.w = cvt_pk_bf16(v1[2], v1[3]);
                    if (isq) *(u32x4*)(Q + (size_t)row * 512 + pn * 256 + bj * HALF + cl) = w;
                    else if (isk) *(u32x4*)(K + (size_t)row * 128 + cl) = w;
                    else if (isv) {
                        const int kvh = wc >> 1, d0 = (wc & 1) * 32 + 8 * fq, b = row >> 12;
                        bf16_t* vp = VT + ((size_t)(b * 2 + kvh) * 64 + d0) * 4096 + pos;
                        vp[0 * 4096] = (bf16_t)(w.x & 0xffffu); vp[1 * 4096] = (bf16_t)(w.x >> 16); vp[2 * 4096] = (bf16_t)(w.y & 0xffffu); vp[3 * 4096] = (bf16_t)(w.y >> 16);
                        vp[4 * 4096] = (bf16_t)(w.z & 0xffffu); vp[5 * 4096] = (bf16_t)(w.z >> 16); vp[6 * 4096] = (bf16_t)(w.w & 0xffffu); vp[7 * 4096] = (bf16_t)(w.w >> 16);
                    } else *(u32x4*)(PC + (size_t)row * 512 + (pn - 3) * 256 + bj * HALF + cl) = w;
                }
            }
    }
};
template <class Epi, class Sched, bool ALIGN_EPI = false, bool SP2 = false>
__device__ __forceinline__ void gemm_phase(PG8_LAS unsigned char* lds, const Gemm g, const Sched& S, const Epi& E) {
    const int tid = threadIdx.x, wid = __builtin_amdgcn_readfirstlane(tid >> 6), lane = tid & 63, wr = wid >> 2, wc = wid & 3, fr = lane & 15, fq = lane >> 4;
    const int K = g.K, nt = K / BK;
    unsigned voffA[2], voffB[2];
#pragma unroll
    for (int i = 0; i < 2; ++i) { int R, C; stage_rc(tid * 16 + i * 8192, R, C); const int Rb = Epi::PERM ? ((R & ~31) + perm32(R & 31)) : R;
        voffA[i] = (unsigned)(R * K + C) * 2u; voffB[i] = (unsigned)(Rb * K + C) * 2u; }
    const size_t kstep = (size_t)(BK * 2);
    const size_t hstep = (size_t)HALF * K * 2;
    const size_t tstep = 2 * hstep;
    const unsigned ldsw = (unsigned)wid * 1024u;
    const int aoff = lds_byte(wr * 64 + fr, fq * 8), boff = lds_byte(wc * 32 + fr, fq * 8);
#define PG8_SA(b, h) (((b) * 2 + (h)) * HTB)
#define PG8_SB(b, h) ((4 + (b) * 2 + (h)) * HTB)
#define PG8_STAGE(bufoff, gbase, voff) do { _Pragma("unroll") for (int _i = 0; _i < 2; ++_i) \
        __builtin_amdgcn_global_load_lds((const unsigned*)((const char*)(gbase) + (voff)[_i]), (PG8_LAS unsigned*)(lds + (bufoff) + ldsw + _i * 8192), 16, 0, 0); } while (0)
#define PG8_LDA(dst, b, h) do { _Pragma("unroll") for (int m = 0; m < 4; ++m) _Pragma("unroll") for (int k = 0; k < 2; ++k) dst[m][k] = *(const PG8_LAS bf16x8*)(lds + PG8_SA(b, h) + aoff + m * 2048 + k * 1024); } while (0)
#define PG8_LDB(dst, b, h) do { _Pragma("unroll") for (int n = 0; n < 2; ++n) _Pragma("unroll") for (int k = 0; k < 2; ++k) dst[n][k] = *(const PG8_LAS bf16x8*)(lds + PG8_SB(b, h) + boff + n * 2048 + k * 1024); } while (0)
#define PG8_MMA(ai, bj, At, Bt) do { __builtin_amdgcn_s_setprio(1); _Pragma("unroll") for (int m = 0; m < 4; ++m) _Pragma("unroll") for (int n = 0; n < 2; ++n) _Pragma("unroll") for (int k = 0; k < 2; ++k) \
        acc[ai][bj][m][n] = __builtin_amdgcn_mfma_f32_16x16x32_bf16(Bt[n][k], At[m][k], acc[ai][bj][m][n], 0, 0, 0); __builtin_amdgcn_s_setprio(0); } while (0)
#define PG8_WAIT_V(n) asm volatile("s_waitcnt vmcnt(" #n ")" ::: "memory")
#define PG8_WAIT_L(n) asm volatile("s_waitcnt lgkmcnt(" #n ")" ::: "memory")
#define PG8_BAR __builtin_amdgcn_s_barrier()
#define PG8_SCHED __builtin_amdgcn_sched_barrier(0)
    Unit cur, nxt; int ui = 0;
    if (!S.next(0, cur)) return;
    f32x4 acc[2][2][4][2];
#pragma unroll
    for (int a = 0; a < 2; ++a)
#pragma unroll
        for (int b = 0; b < 2; ++b)
#pragma unroll
            for (int m = 0; m < 4; ++m)
#pragma unroll
                for (int n = 0; n < 2; ++n) acc[a][b][m][n] = (f32x4){0.f, 0.f, 0.f, 0.f};
    bf16x8 At[4][2], B0[2][2], B1[2][2];
    const char* cA = (const char*)g.A + (size_t)cur.pm * tstep; const char* cB = (const char*)g.Bt + (size_t)cur.pn * tstep;
    S.a_ready(cur);
    if constexpr (SP2) {
        PG8_STAGE(PG8_SB(0, 0), cB, voffB); PG8_STAGE(PG8_SB(0, 1), cB + hstep, voffB); PG8_STAGE(PG8_SA(0, 0), cA, voffA); PG8_STAGE(PG8_SA(0, 1), cA + hstep, voffA);
        if (wr == 1) PG8_BAR;
        PG8_WAIT_V(2); PG8_BAR;
        PG8_STAGE(PG8_SB(1, 0), cB + kstep, voffB); PG8_STAGE(PG8_SA(1, 0), cA + kstep, voffA); PG8_STAGE(PG8_SB(1, 1), cB + hstep + kstep, voffB);
        PG8_WAIT_V(6); PG8_BAR;
    } else {
        PG8_STAGE(PG8_SB(0, 0), cB, voffB); PG8_STAGE(PG8_SA(0, 0), cA, voffA); PG8_STAGE(PG8_SB(0, 1), cB + hstep, voffB); PG8_STAGE(PG8_SA(0, 1), cA + hstep, voffA);
        if (wr == 1) PG8_BAR;
        PG8_WAIT_V(4); PG8_BAR;
        PG8_STAGE(PG8_SB(1, 0), cB + kstep, voffB); PG8_STAGE(PG8_SA(1, 0), cA + kstep, voffA); PG8_STAGE(PG8_SB(1, 1), cB + hstep + kstep, voffB);
        PG8_WAIT_V(6); PG8_BAR;
    }
    for (;;) {
        const bool has_next = S.next(ui + 1, nxt);
        const char* nA = has_next ? (const char*)g.A + (size_t)nxt.pm * tstep : cA; const char* nB = has_next ? (const char*)g.Bt + (size_t)nxt.pn * tstep : cB;
        for (int t = 0; t < nt; t += 2) {
            const bool last = (t == nt - 2);
            const char* a1 = cA + (size_t)(t + 1) * kstep;
            const char* a2 = last ? nA : cA + (size_t)(t + 2) * kstep; const char* b2 = last ? nB : cB + (size_t)(t + 2) * kstep;
            const char* a3 = a2 + kstep; const char* b3 = b2 + kstep;
            if (last && has_next) S.a_ready(nxt);
            if constexpr (SP2) {
            PG8_LDB(B0, 0, 0); PG8_LDB(B1, 0, 1); PG8_SCHED; PG8_LDA(At, 0, 0); PG8_STAGE(PG8_SA(1, 1), a1 + hstep, voffA);
            PG8_WAIT_V(8); PG8_WAIT_L(0); PG8_BAR; PG8_MMA(0, 0, At, B0); PG8_MMA(0, 1, At, B1); PG8_BAR; PG8_SCHED;
            PG8_LDA(At, 0, 1); PG8_STAGE(PG8_SB(0, 0), b2, voffB); PG8_STAGE(PG8_SB(0, 1), b2 + hstep, voffB); PG8_STAGE(PG8_SA(0, 0), a2, voffA);
            PG8_WAIT_V(8); PG8_WAIT_L(0); PG8_BAR; PG8_MMA(1, 0, At, B0); PG8_MMA(1, 1, At, B1); PG8_BAR; PG8_SCHED;
            PG8_LDB(B0, 1, 0); PG8_LDB(B1, 1, 1); PG8_SCHED; PG8_LDA(At, 1, 0); PG8_STAGE(PG8_SA(0, 1), a2 + hstep, voffA);
            PG8_WAIT_V(8); PG8_WAIT_L(0); PG8_BAR; PG8_MMA(0, 0, At, B0); PG8_MMA(0, 1, At, B1); PG8_BAR; PG8_SCHED;
            PG8_LDA(At, 1, 1); PG8_STAGE(PG8_SB(1, 0), b3, voffB); PG8_STAGE(PG8_SB(1, 1), b3 + hstep, voffB); PG8_STAGE(PG8_SA(1, 0), a3, voffA);
            PG8_WAIT_V(8); PG8_WAIT_L(0); PG8_BAR; PG8_MMA(1, 0, At, B0); PG8_MMA(1, 1, At, B1); PG8_BAR; PG8_SCHED;
            } else {
            PG8_LDB(B0, 0, 0); PG8_SCHED; PG8_LDA(At, 0, 0); PG8_STAGE(PG8_SA(1, 1), a1 + hstep, voffA);
            PG8_WAIT_L(8); PG8_BAR; PG8_WAIT_L(0); PG8_MMA(0, 0, At, B0); PG8_BAR; PG8_SCHED;
            PG8_LDB(B1, 0, 1); PG8_STAGE(PG8_SB(0, 0), b2, voffB);
            PG8_BAR; PG8_WAIT_L(0); PG8_MMA(0, 1, At, B1); PG8_BAR;
            PG8_LDA(At, 0, 1); PG8_STAGE(PG8_SA(0, 0), a2, voffA);
            PG8_BAR; PG8_WAIT_L(0); PG8_MMA(1, 0, At, B0); PG8_BAR; PG8_SCHED;
            PG8_STAGE(PG8_SB(0, 1), b2 + hstep, voffB);
            PG8_WAIT_V(6); PG8_BAR; PG8_MMA(1, 1, At, B1); PG8_BAR;
            PG8_LDB(B0, 1, 0); PG8_SCHED; PG8_LDA(At, 1, 0); PG8_STAGE(PG8_SA(0, 1), a2 + hstep, voffA);
            PG8_WAIT_L(8); PG8_BAR; PG8_WAIT_L(0); PG8_MMA(0, 0, At, B0); PG8_BAR; PG8_SCHED;
            PG8_LDB(B1, 1, 1); PG8_STAGE(PG8_SB(1, 0), b3, voffB);
            PG8_BAR; PG8_WAIT_L(0); PG8_MMA(0, 1, At, B1); PG8_BAR;
            PG8_LDA(At, 1, 1); PG8_STAGE(PG8_SA(1, 0), a3, voffA);
            PG8_BAR; PG8_WAIT_L(0); PG8_MMA(1, 0, At, B0); PG8_BAR; PG8_SCHED;
            PG8_STAGE(PG8_SB(1, 1), b3 + hstep, voffB);
            PG8_WAIT_V(6); PG8_BAR; PG8_MMA(1, 1, At, B1); PG8_BAR;
            }
        }
        if constexpr (ALIGN_EPI) { if (wr == 0) PG8_BAR; }
        if constexpr (!Epi::AFTER_DRAIN) { E(acc, cur, wr, wc, fr, fq); S.done(cur); }
        if (!has_next) break;
#pragma unroll
        for (int a = 0; a < 2; ++a)
#pragma unroll
            for (int b = 0; b < 2; ++b)
#pragma unroll
                for (int m = 0; m < 4; ++m)
#pragma unroll
                    for (int n = 0; n < 2; ++n) acc[a][b][m][n] = (f32x4){0.f, 0.f, 0.f, 0.f};
        cur = nxt; cA = nA; cB = nB; ++ui;
        if constexpr (ALIGN_EPI) { if (wr == 1) PG8_BAR; }
    }
    PG8_WAIT_V(0);
    if constexpr (!ALIGN_EPI) { if (wr == 0) PG8_BAR; }
    PG8_BAR;
    if constexpr (Epi::AFTER_DRAIN) { E.fused(acc, cur, wr, wc, fr, fq, lds, wid, lane); S.done(cur); }
#undef PG8_SA
#undef PG8_SB
#undef PG8_STAGE
#undef PG8_LDA
#undef PG8_LDB
#undef PG8_MMA
#undef PG8_WAIT_V
#undef PG8_WAIT_L
#undef PG8_BAR
#undef PG8_SCHED
}
}
constexpr int NWAVES = 8, NTHR = NWAVES * 64;
constexpr int BATCH = 8, SEQ = 4096, DM = 1024, FF = 2816, M = BATCH * SEQ, INW = 1280, NGU = 2 * FF;
constexpr int N_PHASES = 9;
#ifndef MK_N_LAUNCHES
#define MK_N_LAUNCHES 1
#endif
#ifndef PROBE_REP
#define PROBE_REP -1
#endif
#define REPS(k) ((PROBE_REP == (k)) ? 2 : 1)
constexpr size_t MiB = 1u << 20;
constexpr size_t WS_WGU1 = 0, WS_WD1 = 11 * MiB, WS_WGU2 = 17 * MiB, WS_WD2 = 28 * MiB, WS_WIN = 34 * MiB, WS_WOUT = 37 * MiB;
constexpr size_t WS_PWT = 39 * MiB, WS_ROPE = 39 * MiB + 512 * 1024, WS_SS0 = 40 * MiB, WS_SS1 = 42 * MiB, WS_SS2 = 44 * MiB, WS_SS3 = 46 * MiB;
constexpr size_t WS_CTL = 39 * MiB + 768 * 1024, CTL_BYTES = 16384;
constexpr size_t WS_A = 48 * MiB;
constexpr size_t WS_B = 112 * MiB;
constexpr size_t WS_HID = 176 * MiB;
constexpr size_t WS_Q = WS_HID, WS_K = WS_HID + 32 * MiB, WS_VT = WS_HID + 40 * MiB, WS_PC = WS_HID + 48 * MiB;
constexpr size_t WS_END = 352 * MiB;
static_assert(WS_WD1 >= (size_t)NGU * DM * 2 && WS_WGU2 - WS_WD1 >= (size_t)DM * FF * 2 && WS_WIN - WS_WD2 >= (size_t)DM * FF * 2 && WS_WOUT - WS_WIN >= (size_t)INW * DM * 2, "ws map");
constexpr int LDS_BYTES = 147456;

#define GAS __attribute__((address_space(1)))
#define LAS __attribute__((address_space(3)))
typedef unsigned short bf16;
typedef unsigned v4u __attribute__((ext_vector_type(4)));
typedef unsigned v2u __attribute__((ext_vector_type(2)));
typedef float f32x4 __attribute__((ext_vector_type(4)));
typedef float f32x16 __attribute__((ext_vector_type(16)));
typedef short bf16x8 __attribute__((ext_vector_type(8)));
#define LDS_WAIT() asm volatile("s_waitcnt lgkmcnt(0)" ::: "memory")
__device__ __forceinline__ unsigned pk2(float lo, float hi) { return pg8::cvt_pk_bf16(lo, hi); }
__device__ __forceinline__ float bf_lo(unsigned w) { return __uint_as_float(w << 16); }
__device__ __forceinline__ float bf_hi(unsigned w) { return __uint_as_float(w & 0xffff0000u); }
__device__ __forceinline__ float wave_sum(float v) {
#pragma unroll
    for (int o = 1; o < 64; o <<= 1) v += __shfl_xor(v, o);
    return v;
}

__device__ __forceinline__ void transpose_item(const float* W, int ldw, int n0, int k0, bf16* WT, int ldt, int r0, const float* gain, LAS float* scr, int lane) {
#pragma unroll 8
    for (int i = 0; i < 32; ++i) { const int kk = 2 * i + (lane >> 5); float v = W[(size_t)(k0 + kk) * ldw + n0 + (lane & 31)]; if (gain) v *= gain[k0 + kk]; scr[kk * 33 + (lane & 31)] = v; }
    LDS_WAIT(); asm volatile("" ::: "memory");
    const int c = lane & 7;
#pragma unroll
    for (int j = 0; j < 4; ++j) { const int n = (lane >> 3) + 8 * j; const LAS float* s = scr + (8 * c) * 33 + n;
        v4u o; o.x = pk2(s[0 * 33], s[1 * 33]); o.y = pk2(s[2 * 33], s[3 * 33]); o.z = pk2(s[4 * 33], s[5 * 33]); o.w = pk2(s[6 * 33], s[7 * 33]);
        *(v4u*)(WT + (size_t)(r0 + n) * ldt + k0 + 8 * c) = o; }
    LDS_WAIT(); asm volatile("" ::: "memory");
}
__device__ __forceinline__ void gu_item(const float* Wg, const float* Wu, const float* gain, bf16* WT, int r, LAS float* scr, int lane) {
    const int kb = r / 176, nb = r % 176, pn = nb >> 3, bj = (nb >> 2) & 1, j0 = (nb & 3) * 32;
    transpose_item(bj ? Wu : Wg, FF, 128 * pn + j0, kb * 64, WT, DM, nb * 32, gain, scr, lane);
}
struct Ptrs {
    const float *x, *g1, *Wg1, *Wu1, *Wd1, *gm, *Win, *sink, *pw, *pscale, *Wout, *g2, *Wg2, *Wu2, *Wd2, *gf;
    float* out;
    bf16 *WGU1, *WD1, *WGU2, *WD2, *WIN, *WOUT, *PWT, *XA, *HB, *HID, *Q, *K, *VT, *PC;
    float *ROPE, *SS0, *SS1, *SS2, *SS3;
};
__device__ __forceinline__ void p0_prologue(const Ptrs& P, LAS unsigned char* lds, int gw, int NGW, int wave, int lane) {
    LAS float* scr = (LAS float*)(lds + wave * 16384);
    constexpr int I_GU = 16 * 176, I_D = 44 * 32, I_IN = 16 * 40, I_OUT = 16 * 32, I_PW = 32;
    constexpr int NITEMS = 2 * I_GU + 2 * I_D + I_IN + I_OUT + I_PW;
    for (int it = gw; it < NITEMS; it += NGW) {
        int r = it;
        if (r < I_GU) { gu_item(P.Wg1, P.Wu1, P.g1, P.WGU1, r, scr, lane); continue; } r -= I_GU;
        if (r < I_GU) { gu_item(P.Wg2, P.Wu2, P.g2, P.WGU2, r, scr, lane); continue; } r -= I_GU;
        if (r < I_D) { transpose_item(P.Wd1, DM, (r & 31) * 32, (r >> 5) * 64, P.WD1, FF, (r & 31) * 32, nullptr, scr, lane); continue; } r -= I_D;
        if (r < I_D) { transpose_item(P.Wd2, DM, (r & 31) * 32, (r >> 5) * 64, P.WD2, FF, (r & 31) * 32, nullptr, scr, lane); continue; } r -= I_D;
        if (r < I_IN) { const int kb = r / 40, nb = r % 40; transpose_item(P.Win, INW, nb * 32, kb * 64, P.WIN, DM, nb * 32, P.gm, scr, lane); continue; } r -= I_IN;
        if (r < I_OUT) { transpose_item(P.Wout, DM, (r & 31) * 32, (r >> 5) * 64, P.WOUT, DM, (r & 31) * 32, nullptr, scr, lane); continue; } r -= I_OUT;
        { const int g = r >> 3, kb = (r >> 2) & 1, nb = r & 3; transpose_item(P.pw + (size_t)g * 16384, 128, nb * 32, kb * 64, P.PWT + (size_t)g * 16384, 128, nb * 32, nullptr, scr, lane); }
    }
    for (int m = gw; m < M; m += NGW) {
        const f32x4* xr = (const f32x4*)(P.x + (size_t)m * DM) + lane;
        f32x4 v[4]; float s = 0.f;
#pragma unroll
        for (int j = 0; j < 4; ++j) { v[j] = xr[64 * j]; s += (v[j][0] * v[j][0] + v[j][1] * v[j][1]) + (v[j][2] * v[j][2] + v[j][3] * v[j][3]); }
        const float tot = wave_sum(s);
        v2u* o8 = (v2u*)(P.XA + (size_t)m * DM) + lane;
#pragma unroll
        for (int j = 0; j < 4; ++j) { v2u w; w.x = pk2(v[j][0], v[j][1]); w.y = pk2(v[j][2], v[j][3]); o8[64 * j] = w; }
        if (lane < 4) ((f32x4*)(P.SS0 + (size_t)m * 16))[lane] = (f32x4){lane == 0 ? tot : 0.f, 0.f, 0.f, 0.f};
    }
    for (int i = gw * 64 + lane; i < SEQ * 8; i += NGW * 64) {
        const int pos = i >> 3, j = i & 7;
        const float inv = powf(500000.0f, -(float)j * 0.125f);
        const float ang = (float)pos * inv;
        const double a = (double)ang; const double kq = rint(a * 0.63661977236758134308);
        const double y = a - kq * 1.57079632679489661923; const double y2 = y * y;
        const double sy = y * (1.0 + y2 * (-1.0 / 6 + y2 * (1.0 / 120 + y2 * (-1.0 / 5040 + y2 * (1.0 / 362880 - y2 * (1.0 / 39916800))))));
        const double cy = 1.0 + y2 * (-0.5 + y2 * (1.0 / 24 + y2 * (-1.0 / 720 + y2 * (1.0 / 40320 + y2 * (-1.0 / 3628800 + y2 * (1.0 / 479001600))))));
        const int k4 = ((int)kq) & 3;
        const double cs = (k4 == 0) ? cy : (k4 == 1) ? -sy : (k4 == 2) ? -cy : sy;
        const double sn = (k4 == 0) ? sy : (k4 == 1) ? cy : (k4 == 2) ? -sy : -cy;
        P.ROPE[pos * 16 + j] = (float)cs; P.ROPE[pos * 16 + 8 + j] = (float)sn;
    }
}

__device__ __forceinline__ void attn_item(const Ptrs& P, int b, int kvh, int n, int g, int half, int lane) {
    const int ql = lane & 31, hi = lane >> 5, head = kvh * 4 + g, q0 = n * 128 + half * 64;
    const size_t rowbase = (size_t)b * SEQ;
    bf16x8 Qf[2][4];
#pragma unroll
    for (int qb = 0; qb < 2; ++qb)
#pragma unroll
        for (int ks = 0; ks < 4; ++ks) Qf[qb][ks] = *(const bf16x8*)(P.Q + (rowbase + q0 + 32 * qb + ql) * 512 + head * 64 + 16 * ks + 8 * hi);
    f32x16 O[2][2];
#pragma unroll
    for (int db = 0; db < 2; ++db)
#pragma unroll
        for (int qb = 0; qb < 2; ++qb)
#pragma unroll
            for (int v = 0; v < 16; ++v) O[db][qb][v] = 0.f;
    const float sk = P.sink[head] * 1.44269504089f;
    float mrun[2] = {sk, sk}, lrun[2] = {hi == 0 ? 1.f : 0.f, hi == 0 ? 1.f : 0.f};
    const int pr = 16 * (ql >> 4) + 8 * ((ql >> 2) & 1) + (ql & 3) + 4 * ((ql >> 3) & 1);
    const int t0 = q0 >> 5; const int kt_lo = (t0 - 4) < 0 ? 0 : (t0 - 4), kt_hi = (t0 + 5) > 127 ? 127 : (t0 + 5);
    const bf16* Kp = P.K + rowbase * 128 + kvh * 64 + 8 * hi;
    const bf16* Vp = P.VT + ((size_t)(b * 2 + kvh) * 64 + ql) * SEQ + 8 * hi;
    for (int kt = kt_lo; kt <= kt_hi; ++kt) {
        const int kbase = kt * 32;
        bf16x8 Kf[4], Vf[2][2];
#pragma unroll
        for (int ks = 0; ks < 4; ++ks) Kf[ks] = *(const bf16x8*)(Kp + (size_t)(kbase + pr) * 128 + 16 * ks);
#pragma unroll
        for (int db = 0; db < 2; ++db)
#pragma unroll
            for (int t = 0; t < 2; ++t) Vf[db][t] = *(const bf16x8*)(Vp + (size_t)db * 32 * SEQ + kbase + 16 * t);
        f32x16 S[2];
#pragma unroll
        for (int qb = 0; qb < 2; ++qb) {
#pragma unroll
            for (int v = 0; v < 16; ++v) S[qb][v] = 0.f;
#pragma unroll
            for (int ks = 0; ks < 4; ++ks) S[qb] = __builtin_amdgcn_mfma_f32_32x32x16_bf16(Kf[ks], Qf[qb][ks], S[qb], 0, 0, 0);
        }
        const bool edge = (kbase < q0 - 64) || (kbase > q0 + 96);
        if (edge) {
#pragma unroll
            for (int qb = 0; qb < 2; ++qb) { const int q = q0 + 32 * qb + ql;
#pragma unroll
                for (int v = 0; v < 16; ++v) { const int kk = kbase + 16 * (v >> 3) + 8 * hi + (v & 7); const int dd = q - kk; if (dd > 128 || dd < -128) S[qb][v] = -1e30f; } }
        }
        bf16x8 Pb[2][2];
#pragma unroll
        for (int qb = 0; qb < 2; ++qb) {
            float mt = S[qb][0];
#pragma unroll
            for (int v = 1; v < 16; ++v) mt = fmaxf(mt, S[qb][v]);
            mt = fmaxf(mt, __shfl_xor(mt, 32));
            const float mn = fmaxf(mrun[qb], mt); const float alpha = __builtin_amdgcn_exp2f(mrun[qb] - mn); mrun[qb] = mn;
            float ps = 0.f;
#pragma unroll
            for (int v = 0; v < 16; ++v) { const float p = __builtin_amdgcn_exp2f(S[qb][v] - mn); S[qb][v] = p; ps += p; }
            lrun[qb] = lrun[qb] * alpha + ps;
#pragma unroll
            for (int db = 0; db < 2; ++db)
#pragma unroll
                for (int v = 0; v < 16; ++v) O[db][qb][v] *= alpha;
#pragma unroll
            for (int t = 0; t < 2; ++t) { v4u w; w.x = pk2(S[qb][8 * t + 0], S[qb][8 * t + 1]); w.y = pk2(S[qb][8 * t + 2], S[qb][8 * t + 3]); w.z = pk2(S[qb][8 * t + 4], S[qb][8 * t + 5]); w.w = pk2(S[qb][8 * t + 6], S[qb][8 * t + 7]);
                Pb[qb][t] = __builtin_bit_cast(bf16x8, w); }
        }
#pragma unroll
        for (int db = 0; db < 2; ++db)
#pragma unroll
            for (int qb = 0; qb < 2; ++qb)
#pragma unroll
                for (int t = 0; t < 2; ++t) O[db][qb] = __builtin_amdgcn_mfma_f32_32x32x16_bf16(Vf[db][t], Pb[qb][t], O[db][qb], 0, 0, 0);
    }
#pragma unroll
    for (int qb = 0; qb < 2; ++qb) {
        const float lt = lrun[qb] + __shfl_xor(lrun[qb], 32); const float inv = 1.0f / lt;
        bf16* op = P.XA + (rowbase + q0 + 32 * qb + ql) * 1024 + head * 64 + 4 * hi;
#pragma unroll
        for (int db = 0; db < 2; ++db)
#pragma unroll
            for (int c = 0; c < 4; ++c) { v2u w; w.x = pk2(O[db][qb][4 * c + 0] * inv, O[db][qb][4 * c + 1] * inv); w.y = pk2(O[db][qb][4 * c + 2] * inv, O[db][qb][4 * c + 3] * inv);
                *(v2u*)(op + 32 * db + 8 * c) = w; }
    }
}
__device__ __forceinline__ void pool_item(const Ptrs& P, int tile, int g, int lane) {
    const int tl = lane & 31, hi = lane >> 5, t = tile * 32 + tl, s = t & (SEQ - 1), half = 1 << g;
    const int a1 = (s - half) < 0 ? 0 : (s - half), b1 = (s + half) > SEQ ? SEQ : (s + half);
    const int a2 = (s - half + 1) < 0 ? 0 : (s - half + 1), b2 = (s + half + 1) > SEQ ? SEQ : (s + half + 1);
    const float w1 = 0.5f / (float)(b1 - a1), w2 = 0.5f / (float)(b2 - a2);
    float acc[8][8];
#pragma unroll
    for (int ks = 0; ks < 8; ++ks)
#pragma unroll
        for (int e = 0; e < 8; ++e) acc[ks][e] = 0.f;
    const bf16* base = P.PC + (size_t)t * 512 + g * 128 + 8 * hi;
    for (int dl = -half; dl <= half; ++dl) {
        const int sp = s + dl; const bool valid = (sp >= 0) && (sp < SEQ);
        float w = (dl == -half) ? w1 : ((dl == half) ? w2 : (w1 + w2));
        if (!valid) w = 0.f;
        if (dl == 0) w -= 1.f;
        const bf16* p = base + (valid ? dl : 0) * 512;
#pragma unroll
        for (int ks = 0; ks < 8; ++ks) { const v4u raw = *(const v4u*)(p + 16 * ks);
            acc[ks][0] += w * bf_lo(raw.x); acc[ks][1] += w * bf_hi(raw.x); acc[ks][2] += w * bf_lo(raw.y); acc[ks][3] += w * bf_hi(raw.y);
            acc[ks][4] += w * bf_lo(raw.z); acc[ks][5] += w * bf_hi(raw.z); acc[ks][6] += w * bf_lo(raw.w); acc[ks][7] += w * bf_hi(raw.w); }
    }
    bf16x8 df[8];
#pragma unroll
    for (int ks = 0; ks < 8; ++ks) { v4u w; w.x = pk2(acc[ks][0], acc[ks][1]); w.y = pk2(acc[ks][2], acc[ks][3]); w.z = pk2(acc[ks][4], acc[ks][5]); w.w = pk2(acc[ks][6], acc[ks][7]); df[ks] = __builtin_bit_cast(bf16x8, w); }
    bf16* op = P.XA + (size_t)t * 1024 + 512 + g * 128 + 4 * hi;
    const float* scp = P.pscale + g * 128 + 4 * hi;
#pragma unroll
    for (int nb = 0; nb < 4; ++nb) {
        f32x16 o;
#pragma unroll
        for (int v = 0; v < 16; ++v) o[v] = 0.f;
#pragma unroll
        for (int ks = 0; ks < 8; ++ks) { const bf16x8 wf = *(const bf16x8*)(P.PWT + ((size_t)(g * 128 + 32 * nb + tl)) * 128 + 16 * ks + 8 * hi); o = __builtin_amdgcn_mfma_f32_32x32x16_bf16(wf, df[ks], o, 0, 0, 0); }
#pragma unroll
        for (int c = 0; c < 4; ++c) { const f32x4 sc = *(const f32x4*)(scp + 32 * nb + 8 * c);
            v2u w; w.x = pk2(o[4 * c + 0] * sc[0], o[4 * c + 1] * sc[1]); w.y = pk2(o[4 * c + 2] * sc[2], o[4 * c + 3] * sc[3]); *(v2u*)(op + 32 * nb + 8 * c) = w; }
    }
}

#define XB_TMO      128
#define XB_XCNT(j)  (256  + 64 * (j))
#define XB_XSUB(j)  (1280 + 64 * (j))
#define XB_XGEN(j)  (2304 + 64 * (j))
#define XB_TOP      3328
#define XB_TOPGEN   3392
#define XCD_BAR_WORDS 3456
#define XB_SPIN_CAP (1u << 18)

__device__ __forceinline__ unsigned xb_ld(unsigned* p)              { return __hip_atomic_load(p, __ATOMIC_RELAXED, __HIP_MEMORY_SCOPE_AGENT); }
__device__ __forceinline__ unsigned xb_add(unsigned* p, unsigned v) { return __hip_atomic_fetch_add(p, v, __ATOMIC_RELAXED, __HIP_MEMORY_SCOPE_AGENT); }
__device__ __forceinline__ unsigned xb_xcc_id() { return (unsigned)__builtin_amdgcn_s_getreg((3 << 11) | 20) & 0xFu; }
#define XB_SPIN(cond, bar) do { unsigned _sp = 0; while (cond) { __builtin_amdgcn_s_sleep(1); \
    if ((++_sp & 255u) == 0u) { if (xb_ld(&(bar)[XB_TMO])) break; if (_sp > XB_SPIN_CAP) { atomicAdd(&(bar)[XB_TMO], 1u); break; } } } } while (0)

struct XcdBarrier {
    unsigned* bar; unsigned x;
    volatile LAS unsigned* st;
};

__device__ __forceinline__ XcdBarrier xcd_barrier_post(unsigned* bar, volatile LAS unsigned* st) {
    XcdBarrier b; b.bar = bar; b.x = xb_xcc_id(); b.st = st;
    if (threadIdx.x == 0) (void)xb_add(&bar[XB_XCNT(b.x)], 1u);
    return b;
}
__device__ __forceinline__ void xcd_barrier_complete(unsigned* bar, unsigned x, unsigned& nloc, unsigned& nx) {
    const unsigned G = gridDim.x * gridDim.y * gridDim.z;
    unsigned sum, cnt, mine, sp = 0u;
    for (;;) {
        sum = 0u; cnt = 0u; mine = 0u;
#pragma unroll
        for (unsigned j = 0; j < 16; ++j) { const unsigned c = xb_ld(&bar[XB_XCNT(j)]); sum += c; cnt += (c > 0u) ? 1u : 0u; mine = (j == x) ? c : mine; }
        if (sum == G) break;
        __builtin_amdgcn_s_sleep(1);
        if ((++sp & 255u) == 0u) { if (xb_ld(&bar[XB_TMO])) break; if (sp > XB_SPIN_CAP) { atomicAdd(&bar[XB_TMO], 1u); break; } }
    }
    nloc = mine > 0u ? mine : 1u; nx = cnt > 0u ? cnt : 1u;
}

__device__ __forceinline__ void xcd_barrier(const XcdBarrier& b) {
    asm volatile("s_waitcnt vmcnt(0)" ::: "memory");
    __syncthreads();
    if (threadIdx.x == 0) {
        unsigned* bar = b.bar;
        __builtin_amdgcn_s_waitcnt(0);
        unsigned nloc = b.st[0], nx = b.st[1];
        if (nloc == 0u) { xcd_barrier_complete(bar, b.x, nloc, nx); b.st[0] = nloc; b.st[1] = nx; }
        const unsigned old = xb_add(&bar[XB_XSUB(b.x)], 1u);
        const unsigned gen = old / nloc;
        if (old + 1u == (gen + 1u) * nloc) {
            __builtin_amdgcn_fence(__ATOMIC_RELEASE, "agent");
            asm volatile("s_waitcnt vmcnt(0)" ::: "memory");
            const unsigned og = xb_add(&bar[XB_TOP], 1u);
            const unsigned tg = og / nx;
            if (og + 1u == (tg + 1u) * nx) xb_add(&bar[XB_TOPGEN], 1u);
            else XB_SPIN(xb_ld(&bar[XB_TOPGEN]) == tg, bar);
            __builtin_amdgcn_fence(__ATOMIC_ACQUIRE, "agent");
            xb_add(&bar[XB_XGEN(b.x)], 1u);
            asm volatile("s_waitcnt vmcnt(0)" ::: "memory");
        } else {
            XB_SPIN(xb_ld(&bar[XB_XGEN(b.x)]) == gen, bar);
            __builtin_amdgcn_fence(__ATOMIC_ACQUIRE, "agent");
            asm volatile("s_waitcnt vmcnt(0)" ::: "memory");
        }
    }
    __syncthreads();
}

struct Args { const float* in[16]; float* out; unsigned char* ws; int ph_lo, ph_hi; };
__global__ void __launch_bounds__(NTHR, 2) fwd_mega(Args args) {
    extern __shared__ __attribute__((aligned(16))) unsigned char lds_raw[];
    LAS unsigned char* lds = (LAS unsigned char*)lds_raw;
    cg::grid_group grid = cg::this_grid();
    const int tid = threadIdx.x, lane = tid & 63, wave = __builtin_amdgcn_readfirstlane(tid >> 6);
    const int G = gridDim.x, bx = blockIdx.x;
    const int gw = bx * NWAVES + wave, NGW = G * NWAVES;
    unsigned char* ws = args.ws;
    Ptrs P;
    P.x = args.in[0]; P.g1 = args.in[1]; P.Wg1 = args.in[2]; P.Wu1 = args.in[3]; P.Wd1 = args.in[4]; P.gm = args.in[5]; P.Win = args.in[6]; P.sink = args.in[7];
    P.pw = args.in[8]; P.pscale = args.in[9]; P.Wout = args.in[10]; P.g2 = args.in[11]; P.Wg2 = args.in[12]; P.Wu2 = args.in[13]; P.Wd2 = args.in[14]; P.gf = args.in[15];
    P.out = args.out;
    P.WGU1 = (bf16*)(ws + WS_WGU1); P.WD1 = (bf16*)(ws + WS_WD1); P.WGU2 = (bf16*)(ws + WS_WGU2); P.WD2 = (bf16*)(ws + WS_WD2); P.WIN = (bf16*)(ws + WS_WIN); P.WOUT = (bf16*)(ws + WS_WOUT);
    P.PWT = (bf16*)(ws + WS_PWT); P.XA = (bf16*)(ws + WS_A); P.HB = (bf16*)(ws + WS_B); P.HID = (bf16*)(ws + WS_HID);
    P.Q = (bf16*)(ws + WS_Q); P.K = (bf16*)(ws + WS_K); P.VT = (bf16*)(ws + WS_VT); P.PC = (bf16*)(ws + WS_PC);
    P.ROPE = (float*)(ws + WS_ROPE); P.SS0 = (float*)(ws + WS_SS0); P.SS1 = (float*)(ws + WS_SS1); P.SS2 = (float*)(ws + WS_SS2); P.SS3 = (float*)(ws + WS_SS3);
    const int lo = args.ph_lo, hi = args.ph_hi;
    volatile LAS unsigned* MISC = (volatile LAS unsigned*)(lds + 131072 + 320);
    if (tid < 32) MISC[tid] = 0u;
    __syncthreads();
    XcdBarrier bar = xcd_barrier_post((unsigned*)(ws + WS_CTL), MISC + 8);
#define IN(k) (lo <= (k) && (k) < hi)
#define SEAM(k) do { if (IN(k) && IN((k) + 1)) { if ((k) == 0) grid.sync(); else xcd_barrier(bar); if (PROBE_REP == 9 && (k) == 1) { for (int z = 0; z < 16; ++z) xcd_barrier(bar); } } } while (0)

    if (IN(0)) { for (int rep = 0; rep < REPS(0); ++rep) p0_prologue(P, lds, gw, NGW, wave, lane); SEAM(0); }
    if (IN(1)) {
        pg8::Gemm g{P.XA, P.WGU1, M, NGU, DM}; pg8::StaticOrder S; S.init(M, NGU, G, bx);
        pg8::EpiSwiglu E{P.HID, FF, P.SS0};
        if (REPS(1) == 2) pg8::gemm_phase<pg8::EpiSwiglu, pg8::StaticOrder, true, true>(lds, g, S, E);
        pg8::gemm_phase<pg8::EpiSwiglu, pg8::StaticOrder, true, true>(lds, g, S, E);
        SEAM(1);
    }
    if (IN(2)) {
        pg8::Gemm g{P.HID, P.WD1, M, DM, FF}; pg8::StaticOrder S; S.init(M, DM, G, bx);
        pg8::EpiResid E{P.x, P.out, P.HB, P.SS1, 0.5f};
        if (REPS(2) == 2) pg8::gemm_phase<pg8::EpiResid, pg8::StaticOrder, true, true>(lds, g, S, E);
        pg8::gemm_phase<pg8::EpiResid, pg8::StaticOrder, true, true>(lds, g, S, E);
        SEAM(2);
    }
    if (IN(3)) {
        pg8::Gemm g{P.HB, P.WIN, M, INW, DM}; pg8::StaticOrder S; S.init(M, INW, G, bx);
        pg8::EpiIn E{P.Q, P.K, P.VT, P.PC, P.SS1, P.ROPE};
        if (REPS(3) == 2) pg8::gemm_phase<pg8::EpiIn, pg8::StaticOrder, true, true>(lds, g, S, E);
        pg8::gemm_phase<pg8::EpiIn, pg8::StaticOrder, true, true>(lds, g, S, E);
        SEAM(3);
    }
    if (IN(4)) {
        for (int rep = 0; rep < REPS(4); ++rep) {
        for (int u = bx; u < BATCH * 2 * 32; u += G) { const int n = u & 31, kvh = (u >> 5) & 1, b = u >> 6; attn_item(P, b, kvh, n, wave >> 1, wave & 1, lane); }
        for (int it = gw; it < 2048; it += NGW) { const int tile = it & 1023, g = it >> 10; pool_item(P, tile, g, lane); pool_item(P, tile, 3 - g, lane); }
        }
        SEAM(4);
    }
    if (IN(5)) {
        pg8::Gemm g{P.XA, P.WOUT, M, DM, DM}; pg8::StaticOrder S; S.init(M, DM, G, bx);
        if (REPS(5) == 2) { pg8::EpiResid E0{P.out, (float*)(ws + WS_HID), (bf16*)(ws + WS_HID + 128 * MiB), P.SS3, 1.0f}; pg8::gemm_phase<pg8::EpiResid, pg8::StaticOrder, true, true>(lds, g, S, E0); }
        pg8::EpiResid E{P.out, P.out, P.HB, P.SS2, 1.0f};
        pg8::gemm_phase<pg8::EpiResid, pg8::StaticOrder, true, true>(lds, g, S, E);
        SEAM(5);
    }
    if (IN(6)) {
        pg8::Gemm g{P.HB, P.WGU2, M, NGU, DM}; pg8::StaticOrder S; S.init(M, NGU, G, bx);
        pg8::EpiSwiglu E{P.HID, FF, P.SS2};
        if (REPS(6) == 2) pg8::gemm_phase<pg8::EpiSwiglu, pg8::StaticOrder, true, true>(lds, g, S, E);
        pg8::gemm_phase<pg8::EpiSwiglu, pg8::StaticOrder, true, true>(lds, g, S, E);
        SEAM(6);
    }
    if (IN(7)) {
        pg8::Gemm g{P.HID, P.WD2, M, DM, FF}; pg8::StaticOrder S; S.init(M, DM, G, bx);
        if (REPS(7) == 2) { pg8::EpiResid E0{P.out, (float*)(ws + WS_A), nullptr, P.SS0, 0.5f}; pg8::gemm_phase<pg8::EpiResid, pg8::StaticOrder, true, true>(lds, g, S, E0); }
        pg8::EpiResid E{P.out, P.out, nullptr, P.SS3, 0.5f};
        pg8::gemm_phase<pg8::EpiResid, pg8::StaticOrder, true, true>(lds, g, S, E);
        SEAM(7);
    }
    if (IN(8)) {
        for (int rep = 0; rep < REPS(8); ++rep)
        for (int m = gw; m < M; m += NGW) {
            float q = P.SS3[(size_t)m * 16 + (lane & 15)];
            q += __shfl_xor(q, 1); q += __shfl_xor(q, 2); q += __shfl_xor(q, 4); q += __shfl_xor(q, 8);
            const float rs = 1.0f / sqrtf(q * (1.0f / 1024.0f) + pg8::RMS_EPS);
            f32x4* xr = (f32x4*)(P.out + (size_t)m * DM) + lane; const f32x4* gr = (const f32x4*)P.gf + lane;
#pragma unroll
            for (int j = 0; j < 4; ++j) { const f32x4 v = xr[64 * j]; f32x4* dst = (REPS(8) == 2 && rep == 0) ? ((f32x4*)(ws + WS_A) + (size_t)m * 256 + lane) : xr; dst[64 * j] = v * rs * gr[64 * j]; }
        }
    }
#undef IN
#undef SEAM
}

extern "C" void kernel_launch(void* const* d_in, const int* in_sizes, int n_in, void* d_out, int out_size, void* d_ws, size_t ws_size, hipStream_t stream) {
    static int grid = 0;
    if (grid == 0) {
        if (n_in != 16 || in_sizes[0] != M * DM || out_size != M * DM || ws_size < WS_END) { fprintf(stderr, "kernel_launch: unexpected shapes (n_in %d, in0 %d, out %d, ws %zu); nothing launched\n", n_in, n_in > 0 ? in_sizes[0] : -1, out_size, ws_size); grid = -1; return; }
        int dev = 0, cus = 0, per_cu = 0;
        if (hipGetDevice(&dev) != hipSuccess || hipDeviceGetAttribute(&cus, hipDeviceAttributeMultiprocessorCount, dev) != hipSuccess) { grid = -1; return; }
        if (hipFuncSetAttribute((const void*)fwd_mega, hipFuncAttributeMaxDynamicSharedMemorySize, LDS_BYTES) != hipSuccess) { fprintf(stderr, "kernel_launch: hipFuncSetAttribute failed\n"); grid = -1; return; }
        if (hipOccupancyMaxActiveBlocksPerMultiprocessor(&per_cu, (const void*)fwd_mega, NTHR, LDS_BYTES) != hipSuccess || per_cu < 1) { fprintf(stderr, "kernel_launch: occupancy query says %d blocks per CU\n", per_cu); (void)hipGetLastError(); grid = -1; return; }
        grid = cus * per_cu;
    }
    if (grid < 0) return;
    Args a{};
    for (int i = 0; i < 16; ++i) a.in[i] = (const float*)d_in[i];
    a.out = (float*)d_out; a.ws = (unsigned char*)d_ws;
#if MK_N_LAUNCHES == 1
    if (hipMemsetAsync((char*)d_ws + WS_CTL, 0, CTL_BYTES, stream) != hipSuccess) { fprintf(stderr, "kernel_launch: memset of the barrier words failed\n"); return; }
    a.ph_lo = 0; a.ph_hi = N_PHASES;
    void* kargs[] = {&a};
    hipError_t e = hipLaunchCooperativeKernel((const void*)fwd_mega, dim3(grid), dim3(NTHR), kargs, LDS_BYTES, stream);
    if (e != hipSuccess) fprintf(stderr, "kernel_launch: cooperative launch failed: %s (grid %d)\n", hipGetErrorString(e), grid);
#else
    for (int p = 0; p < N_PHASES; ++p) { a.ph_lo = p; a.ph_hi = p + 1; hipLaunchKernelGGL(fwd_mega, dim3(grid), dim3(NTHR), LDS_BYTES, stream, a); }
#endif
}
```

```cpp
#include <hip/hip_runtime.h>
#include <hip/hip_cooperative_groups.h>
#include <cstdio>
#include <cstdint>
namespace cg = cooperative_groups;
namespace pg8 {
#define PG8_LAS __attribute__((address_space(3)))
typedef unsigned short bf16_t;
typedef short bf16x8 __attribute__((ext_vector_type(8)));
typedef float f32x4 __attribute__((ext_vector_type(4)));
typedef unsigned u32x4 __attribute__((ext_vector_type(4)));
constexpr int BM = 256, BK = 64, HALF = 128, HTB = HALF * BK * 2  , STAGE_BYTES = 8 * HTB, NXCD = 8, WGM = 8;

__host__ __device__ __forceinline__ int lds_byte(int r, int c) { const int st = (r >> 4) * 2 + (c >> 5), rr = r & 15, cc = c & 31, ob = rr * 64 + cc * 2; return st * 1024 + (ob ^ (((ob >> 9) & 1) << 5)); }
__host__ __device__ __forceinline__ void stage_rc(int b, int& R, int& C) { const int st = b / 1024, sb = b % 1024, swz = sb ^ (((sb >> 9) & 1) << 5); R = (st >> 1) * 16 + swz / 64; C = (st & 1) * 32 + (swz % 64) / 2; }
__host__ __device__ __forceinline__ int perm32(int rho) { const int n = rho >> 4, i = rho & 15; return 8 * (i >> 2) + 4 * n + (i & 3); }

struct Unit { int pm, pn; };
struct Gemm { const bf16_t* A; const bf16_t* Bt; int M, N, K; };

struct StaticOrder {
    int nM, nN, nwg, G, c;
    __host__ __device__ void init(int M, int N, int G_, int c_) { nM = M / BM; nN = N / BM; nwg = nM * nN; G = G_; c = c_; }
    __host__ __device__ bool next(int i, Unit& u) const {
        const long L = (long)i * G + c; if (L >= nwg) return false;
        int wgid = (int)L; { const int q = nwg / NXCD, r = nwg % NXCD, xcd = wgid % NXCD, off = wgid / NXCD; wgid = (xcd < r ? xcd * (q + 1) : r * (q + 1) + (xcd - r) * q) + off; }
        const int nig = WGM * nN, gid = wgid / nig, fm = gid * WGM, gsz = (nM - fm) < WGM ? (nM - fm) : WGM;
        u.pm = fm + ((wgid % nig) % gsz); u.pn = (wgid % nig) / gsz; return true;
    }
    __device__ __forceinline__ void a_ready(const Unit&) const {}
    __device__ __forceinline__ void done(const Unit&) const {}
};

__device__ __forceinline__ unsigned cvt_pk_bf16(float lo, float hi) { unsigned r; asm volatile("v_cvt_pk_bf16_f32 %0, %1, %2" : "=v"(r) : "v"(lo), "v"(hi)); return r; }
constexpr float RMS_EPS = 1e-6f;
__device__ __forceinline__ float row_rs(const float* ss, int row) {
    const f32x4* p = (const f32x4*)(ss + (size_t)row * 16);
    const f32x4 a = p[0], b = p[1], c = p[2], d = p[3];
    const f32x4 s = (a + b) + (c + d);
    const float t = (s[0] + s[1]) + (s[2] + s[3]);
    return 1.0f / sqrtf(t * (1.0f / 1024.0f) + RMS_EPS);
}
__device__ __forceinline__ float silu_mul(float g, float u) {
    const float e = __builtin_amdgcn_exp2f(g * -1.44269504089f);
    return g * __builtin_amdgcn_rcpf(1.0f + e) * u;
}
struct EpiSwiglu {
    static constexpr bool PERM = true, AFTER_DRAIN = false;
    bf16_t* O; int ldc; const float* ss;
    __device__ __forceinline__ void operator()(const f32x4 (&acc)[2][2][4][2], const Unit& u, int wr, int wc, int fr, int fq) const {
        const int row0 = u.pm * BM + wr * 64 + fr; const int col0 = u.pn * HALF + wc * 32 + 8 * fq;
#pragma unroll
        for (int ai = 0; ai < 2; ++ai)
#pragma unroll
            for (int m = 0; m < 4; ++m) {
                const int row = row0 + ai * HALF + m * 16; const float rs = row_rs(ss, row);
                const f32x4 g0 = acc[ai][0][m][0] * rs, g1 = acc[ai][0][m][1] * rs, u0 = acc[ai][1][m][0] * rs, u1 = acc[ai][1][m][1] * rs;
                u32x4 w;
                w.x = cvt_pk_bf16(silu_mul(g0[0], u0[0]), silu_mul(g0[1], u0[1])); w.y = cvt_pk_bf16(silu_mul(g0[2], u0[2]), silu_mul(g0[3], u0[3]));
                w.z = cvt_pk_bf16(silu_mul(g1[0], u1[0]), silu_mul(g1[1], u1[1])); w.w = cvt_pk_bf16(silu_mul(g1[2], u1[2]), silu_mul(g1[3], u1[3]));
                *(u32x4*)(O + (size_t)row * ldc + col0) = w;
            }
    }
};
template <bool BASE_BF16> struct EpiResid {
    static constexpr bool PERM = true, AFTER_DRAIN = false;
    const void* base; float* outf; bf16_t* outb; float* ss; float coef;
    __device__ __forceinline__ void operator()(const f32x4 (&acc)[2][2][4][2], const Unit& u, int wr, int wc, int fr, int fq) const {
        const int row0 = u.pm * BM + wr * 64 + fr; const int col0 = u.pn * BM + wc * 32 + 8 * fq;
#pragma unroll
        for (int ai = 0; ai < 2; ++ai)
#pragma unroll
            for (int m = 0; m < 4; ++m) {
                const int row = row0 + ai * HALF + m * 16; float q = 0.f;
#pragma unroll
                for (int bj = 0; bj < 2; ++bj) {
                    const size_t off = (size_t)row * 1024 + col0 + bj * HALF;
                    f32x4 b0, b1;
                    if (BASE_BF16) { const u32x4 r = *(const u32x4*)((const bf16_t*)base + off);
                        b0 = (f32x4){__uint_as_float(r.x << 16), __uint_as_float(r.x & 0xffff0000u), __uint_as_float(r.y << 16), __uint_as_float(r.y & 0xffff0000u)};
                        b1 = (f32x4){__uint_as_float(r.z << 16), __uint_as_float(r.z & 0xffff0000u), __uint_as_float(r.w << 16), __uint_as_float(r.w & 0xffff0000u)}; }
                    else { b0 = *(const f32x4*)((const float*)base + off); b1 = *(const f32x4*)((const float*)base + off + 4); }
                    const f32x4 v0 = b0 + acc[ai][bj][m][0] * coef, v1 = b1 + acc[ai][bj][m][1] * coef;
                    if (outf) { *(f32x4*)(outf + off) = v0; *(f32x4*)(outf + off + 4) = v1; }
                    q += (v0[0] * v0[0] + v0[1] * v0[1]) + (v0[2] * v0[2] + v0[3] * v0[3]) + (v1[0] * v1[0] + v1[1] * v1[1]) + (v1[2] * v1[2] + v1[3] * v1[3]);
                    if (outb) { u32x4 w; w.x = cvt_pk_bf16(v0[0], v0[1]); w.y = cvt_pk_bf16(v0[2], v0[3]); w.z = cvt_pk_bf16(v1[0], v1[1]); w.w = cvt_pk_bf16(v1[2], v1[3]); *(u32x4*)(outb + off) = w; }
                }
                q += __shfl_xor(q, 16); q += __shfl_xor(q, 32);
                if (fq == 0) ss[(size_t)row * 16 + u.pn * 4 + wc] = q;
            }
    }
};
struct EpiIn {
    static constexpr bool PERM = true, AFTER_DRAIN = false;
    bf16_t *Q, *K, *VT, *PC; const float* ss; const float* rope;
    __device__ __forceinline__ void operator()(const f32x4 (&acc)[2][2][4][2], const Unit& u, int wr, int wc, int fr, int fq) const {
        const int row0 = u.pm * BM + wr * 64 + fr; const int cl = wc * 32 + 8 * fq; const int pn = u.pn;
        const bool dorope = ((wc & 1) == 0) && (fq < 2); const float sgn = (fq == 0) ? -1.f : 1.f;
        constexpr float QSCALE = 0.125f * 1.44269504089f;
#pragma unroll
        for (int ai = 0; ai < 2; ++ai)
#pragma unroll
            for (int m = 0; m < 4; ++m) {
                const int row = row0 + ai * HALF + m * 16; const float rs = row_rs(ss, row); const int pos = row & 4095;
                f32x4 c0 = {1.f, 1.f, 1.f, 1.f}, c1 = c0, s0 = {0.f, 0.f, 0.f, 0.f}, s1 = s0;
                if (pn <= 2) { const f32x4* rp = (const f32x4*)(rope + (size_t)pos * 16); c0 = rp[0]; c1 = rp[1]; s0 = rp[2]; s1 = rp[3]; }
#pragma unroll
                for (int bj = 0; bj < 2; ++bj) {
                    f32x4 v0 = acc[ai][bj][m][0] * rs, v1 = acc[ai][bj][m][1] * rs;
                    const bool isq = pn < 2, isk = (pn == 2 && bj == 0), isv = (pn == 2 && bj == 1);
                    if (isq || isk) {
                        f32x4 p0, p1;
#pragma unroll
                        for (int i = 0; i < 4; ++i) { p0[i] = __shfl_xor(v0[i], 16); p1[i] = __shfl_xor(v1[i], 16); }
                        const f32x4 r0 = v0 * c0 + p0 * s0 * sgn, r1 = v1 * c1 + p1 * s1 * sgn;
                        if (dorope) { v0 = r0; v1 = r1; }
                        if (isq) { v0 = v0 * QSCALE; v1 = v1 * QSCALE; }
                    }
                    u32x4 w; w.x = cvt_pk_bf16(v0[0], v0[1]); w.y = cvt_pk_bf16(v0[2], v0[3]); w.z = cvt_pk_bf16(v1[0], v1[1]); w.w = cvt_pk_bf16(v1[2], v1[3]);
                    if (isq) *(u32x4*)(Q + (size_t)row * 512 + pn * 256 + bj * HALF + cl) = w;
                    else if (isk) *(u32x4*)(K + (size_t)row * 128 + cl) = w;
                    else if (isv) {
                        const int kvh = wc >> 1, d0 = (wc & 1) * 32 + 8 * fq, b = row >> 12;
                        bf16_t* vp = VT + ((size_t)(b * 2 + kvh) * 64 + d0) * 4096 + pos;
                        vp[0 * 4096] = (bf16_t)(w.x & 0xffffu); vp[1 * 4096] = (bf16_t)(w.x >> 16); vp[2 * 4096] = (bf16_t)(w.y & 0xffffu); vp[3 * 4096] = (bf16_t)(w.y >> 16);
                        vp[4 * 4096] = (bf16_t)(w.z & 0xffffu); vp[5 * 4096] = (bf16_t)(w.z >> 16); vp[6 * 4096] = (bf16_t)(w.w & 0xffffu); vp[7 * 4096] = (bf16_t)(w.w >> 16);
                    } else *(u32x4*)(PC + (size_t)row * 512 + (pn - 3) * 256 + bj * HALF + cl) = w;
                }
            }
    }
};
template <class Epi, class Sched, bool ALIGN_EPI = false, bool SP2 = false>
__device__ __forceinline__ void gemm_phase(PG8_LAS unsigned char* lds, const Gemm g, const Sched& S, const Epi& E) {
    const int tid = threadIdx.x, wid = __builtin_amdgcn_readfirstlane(tid >> 6), lane = tid & 63, wr = wid >> 2, wc = wid & 3, fr = lane & 15, fq = lane >> 4;
    const int K = g.K, nt = K / BK;
    unsigned voffA[2], voffB[2];
#pragma unroll
    for (int i = 0; i < 2; ++i) { int R, C; stage_rc(tid * 16 + i * 8192, R, C); const int Rb = Epi::PERM ? ((R & ~31) + perm32(R & 31)) : R;
        voffA[i] = (unsigned)(R * K + C) * 2u; voffB[i] = (unsigned)(Rb * K + C) * 2u; }
    const size_t kstep = (size_t)(BK * 2);
    const size_t hstep = (size_t)HALF * K * 2;
    const size_t tstep = 2 * hstep;
    const unsigned ldsw = (unsigned)wid * 1024u;
    const int aoff = lds_byte(wr * 64 + fr, fq * 8), boff = lds_byte(wc * 32 + fr, fq * 8);
#define PG8_SA(b, h) (((b) * 2 + (h)) * HTB)
#define PG8_SB(b, h) ((4 + (b) * 2 + (h)) * HTB)
#define PG8_STAGE(bufoff, gbase, voff) do { _Pragma("unroll") for (int _i = 0; _i < 2; ++_i) \
        __builtin_amdgcn_global_load_lds((const unsigned*)((const char*)(gbase) + (voff)[_i]), (PG8_LAS unsigned*)(lds + (bufoff) + ldsw + _i * 8192), 16, 0, 0); } while (0)
#define PG8_LDA(dst, b, h) do { _Pragma("unroll") for (int m = 0; m < 4; ++m) _Pragma("unroll") for (int k = 0; k < 2; ++k) dst[m][k] = *(const PG8_LAS bf16x8*)(lds + PG8_SA(b, h) + aoff + m * 2048 + k * 1024); } while (0)
#define PG8_LDB(dst, b, h) do { _Pragma("unroll") for (int n = 0; n < 2; ++n) _Pragma("unroll") for (int k = 0; k < 2; ++k) dst[n][k] = *(const PG8_LAS bf16x8*)(lds + PG8_SB(b, h) + boff + n * 2048 + k * 1024); } while (0)
#define PG8_MMA(ai, bj, At, Bt) do { __builtin_amdgcn_s_setprio(1); _Pragma("unroll") for (int m = 0; m < 4; ++m) _Pragma("unroll") for (int n = 0; n < 2; ++n) _Pragma("unroll") for (int k = 0; k < 2; ++k) \
        acc[ai][bj][m][n] = __builtin_amdgcn_mfma_f32_16x16x32_bf16(Bt[n][k], At[m][k], acc[ai][bj][m][n], 0, 0, 0); __builtin_amdgcn_s_setprio(0); } while (0)
#define PG8_WAIT_V(n) asm volatile("s_waitcnt vmcnt(" #n ")" ::: "memory")
#define PG8_WAIT_L(n) asm volatile("s_waitcnt lgkmcnt(" #n ")" ::: "memory")
#define PG8_BAR __builtin_amdgcn_s_barrier()
#define PG8_SCHED __builtin_amdgcn_sched_barrier(0)
    Unit cur, nxt; int ui = 0;
    if (!S.next(0, cur)) return;
    f32x4 acc[2][2][4][2];
#pragma unroll
    for (int a = 0; a < 2; ++a)
#pragma unroll
        for (int b = 0; b < 2; ++b)
#pragma unroll
            for (int m = 0; m < 4; ++m)
#pragma unroll
                for (int n = 0; n < 2; ++n) acc[a][b][m][n] = (f32x4){0.f, 0.f, 0.f, 0.f};
    bf16x8 At[4][2], B0[2][2], B1[2][2];
    const char* cA = (const char*)g.A + (size_t)cur.pm * tstep; const char* cB = (const char*)g.Bt + (size_t)cur.pn * tstep;
    S.a_ready(cur);
    if constexpr (SP2) {
        PG8_STAGE(PG8_SB(0, 0), cB, voffB); PG8_STAGE(PG8_SB(0, 1), cB + hstep, voffB); PG8_STAGE(PG8_SA(0, 0), cA, voffA); PG8_STAGE(PG8_SA(0, 1), cA + hstep, voffA);
        if (wr == 1) PG8_BAR;
        PG8_WAIT_V(2); PG8_BAR;
        PG8_STAGE(PG8_SB(1, 0), cB + kstep, voffB); PG8_STAGE(PG8_SA(1, 0), cA + kstep, voffA); PG8_STAGE(PG8_SB(1, 1), cB + hstep + kstep, voffB);
        PG8_WAIT_V(6); PG8_BAR;
    } else {
        PG8_STAGE(PG8_SB(0, 0), cB, voffB); PG8_STAGE(PG8_SA(0, 0), cA, voffA); PG8_STAGE(PG8_SB(0, 1), cB + hstep, voffB); PG8_STAGE(PG8_SA(0, 1), cA + hstep, voffA);
        if (wr == 1) PG8_BAR;
        PG8_WAIT_V(4); PG8_BAR;
        PG8_STAGE(PG8_SB(1, 0), cB + kstep, voffB); PG8_STAGE(PG8_SA(1, 0), cA + kstep, voffA); PG8_STAGE(PG8_SB(1, 1), cB + hstep + kstep, voffB);
        PG8_WAIT_V(6); PG8_BAR;
    }
    for (;;) {
        const bool has_next = S.next(ui + 1, nxt);
        const char* nA = has_next ? (const char*)g.A + (size_t)nxt.pm * tstep : cA; const char* nB = has_next ? (const char*)g.Bt + (size_t)nxt.pn * tstep : cB;
        for (int t = 0; t < nt; t += 2) {
            const bool last = (t == nt - 2);
            const char* a1 = cA + (size_t)(t + 1) * kstep;
            const char* a2 = last ? nA : cA + (size_t)(t + 2) * kstep; const char* b2 = last ? nB : cB + (size_t)(t + 2) * kstep;
            const char* a3 = a2 + kstep; const char* b3 = b2 + kstep;
            if (last && has_next) S.a_ready(nxt);
            if constexpr (SP2) {
            PG8_LDB(B0, 0, 0); PG8_LDB(B1, 0, 1); PG8_SCHED; PG8_LDA(At, 0, 0); PG8_STAGE(PG8_SA(1, 1), a1 + hstep, voffA);
            PG8_WAIT_V(8); PG8_WAIT_L(0); PG8_BAR; PG8_MMA(0, 0, At, B0); PG8_MMA(0, 1, At, B1); PG8_BAR; PG8_SCHED;
            PG8_LDA(At, 0, 1); PG8_STAGE(PG8_SB(0, 0), b2, voffB); PG8_STAGE(PG8_SB(0, 1), b2 + hstep, voffB); PG8_STAGE(PG8_SA(0, 0), a2, voffA);
            PG8_WAIT_V(8); PG8_WAIT_L(0); PG8_BAR; PG8_MMA(1, 0, At, B0); PG8_MMA(1, 1, At, B1); PG8_BAR; PG8_SCHED;
            PG8_LDB(B0, 1, 0); PG8_LDB(B1, 1, 1); PG8_SCHED; PG8_LDA(At, 1, 0); PG8_STAGE(PG8_SA(0, 1), a2 + hstep, voffA);
            PG8_WAIT_V(8); PG8_WAIT_L(0); PG8_BAR; PG8_MMA(0, 0, At, B0); PG8_MMA(0, 1, At, B1); PG8_BAR; PG8_SCHED;
            PG8_LDA(At, 1, 1); PG8_STAGE(PG8_SB(1, 0), b3, voffB); PG8_STAGE(PG8_SB(1, 1), b3 + hstep, voffB); PG8_STAGE(PG8_SA(1, 0), a3, voffA);
            PG8_WAIT_V(8); PG8_WAIT_L(0); PG8_BAR; PG8_MMA(1, 0, At, B0); PG8_MMA(1, 1, At, B1); PG8_BAR; PG8_SCHED;
            } else {
            PG8_LDB(B0, 0, 0); PG8_SCHED; PG8_LDA(At, 0, 0); PG8_STAGE(PG8_SA(1, 1), a1 + hstep, voffA);
            PG8_WAIT_L(8); PG8_BAR; PG8_WAIT_L(0); PG8_MMA(0, 0, At, B0); PG8_BAR; PG8_SCHED;
            PG8_LDB(B1, 0, 1); PG8_STAGE(PG8_SB(0, 0), b2, voffB);
            PG8_BAR; PG8_WAIT_L(0); PG8_MMA(0, 1, At, B1); PG8_BAR;
            PG8_LDA(At, 0, 1); PG8_STAGE(PG8_SA(0, 0), a2, voffA);
            PG8_BAR; PG8_WAIT_L(0); PG8_MMA(1, 0, At, B0); PG8_BAR; PG8_SCHED;
            PG8_STAGE(PG8_SB(0, 1), b2 + hstep, voffB);
            PG8_WAIT_V(6); PG8_BAR; PG8_MMA(1, 1, At, B1); PG8_BAR;
            PG8_LDB(B0, 1, 0); PG8_SCHED; PG8_LDA(At, 1, 0); PG8_STAGE(PG8_SA(0, 1), a2 + hstep, voffA);
            PG8_WAIT_L(8); PG8_BAR; PG8_WAIT_L(0); PG8_MMA(0, 0, At, B0); PG8_BAR; PG8_SCHED;
            PG8_LDB(B1, 1, 1); PG8_STAGE(PG8_SB(1, 0), b3, voffB);
            PG8_BAR; PG8_WAIT_L(0); PG8_MMA(0, 1, At, B1); PG8_BAR;
            PG8_LDA(At, 1, 1); PG8_STAGE(PG8_SA(1, 0), a3, voffA);
            PG8_BAR; PG8_WAIT_L(0); PG8_MMA(1, 0, At, B0); PG8_BAR; PG8_SCHED;
            PG8_STAGE(PG8_SB(1, 1), b3 + hstep, voffB);
            PG8_WAIT_V(6); PG8_BAR; PG8_MMA(1, 1, At, B1); PG8_BAR;
            }
        }
        if constexpr (ALIGN_EPI) { if (wr == 0) PG8_BAR; }
        if constexpr (!Epi::AFTER_DRAIN) { E(acc, cur, wr, wc, fr, fq); S.done(cur); }
        if (!has_next) break;
#pragma unroll
        for (int a = 0; a < 2; ++a)
#pragma unroll
            for (int b = 0; b < 2; ++b)
#pragma unroll
                for (int m = 0; m < 4; ++m)
#pragma unroll
                    for (int n = 0; n < 2; ++n) acc[a][b][m][n] = (f32x4){0.f, 0.f, 0.f, 0.f};
        cur = nxt; cA = nA; cB = nB; ++ui;
        if constexpr (ALIGN_EPI) { if (wr == 1) PG8_BAR; }
    }
    PG8_WAIT_V(0);
    if constexpr (!ALIGN_EPI) { if (wr == 0) PG8_BAR; }
    PG8_BAR;
    if constexpr (Epi::AFTER_DRAIN) { E.fused(acc, cur, wr, wc, fr, fq, lds, wid, lane); S.done(cur); }
#undef PG8_SA
#undef PG8_SB
#undef PG8_STAGE
#undef PG8_LDA
#undef PG8_LDB
#undef PG8_MMA
#undef PG8_WAIT_V
#undef PG8_WAIT_L
#undef PG8_BAR
#undef PG8_SCHED
}
}
constexpr int NWAVES = 8, NTHR = NWAVES * 64;
constexpr int BATCH = 8, SEQ = 4096, DM = 1024, FF = 2816, M = BATCH * SEQ, INW = 1280, NGU = 2 * FF;
constexpr int N_PHASES = 9;
#ifndef MK_N_LAUNCHES
#define MK_N_LAUNCHES 1
#endif
#ifndef PROBE_REP
#define PROBE_REP -1
#endif
#define REPS(k) ((PROBE_REP == (k)) ? 2 : 1)
constexpr size_t MiB = 1u << 20;
constexpr size_t WS_WGU1 = 0, WS_WD1 = 11 * MiB, WS_WGU2 = 17 * MiB, WS_WD2 = 28 * MiB, WS_WIN = 34 * MiB, WS_WOUT = 37 * MiB;
constexpr size_t WS_PWT = 39 * MiB, WS_ROPE = 39 * MiB + 512 * 1024, WS_SS0 = 40 * MiB, WS_SS1 = 42 * MiB, WS_SS2 = 44 * MiB, WS_SS3 = 46 * MiB;
constexpr size_t WS_CTL = 39 * MiB + 768 * 1024, CTL_BYTES = 16384;
constexpr size_t WS_A = 48 * MiB;
constexpr size_t WS_B = 112 * MiB;
constexpr size_t WS_HID = 176 * MiB;
constexpr size_t WS_Q = WS_HID, WS_K = WS_HID + 32 * MiB, WS_VT = WS_HID + 40 * MiB, WS_PC = WS_HID + 48 * MiB;
constexpr size_t WS_END = 352 * MiB;
static_assert(WS_WD1 >= (size_t)NGU * DM * 2 && WS_WGU2 - WS_WD1 >= (size_t)DM * FF * 2 && WS_WIN - WS_WD2 >= (size_t)DM * FF * 2 && WS_WOUT - WS_WIN >= (size_t)INW * DM * 2, "ws map");
constexpr int LDS_BYTES = 147456;

#define GAS __attribute__((address_space(1)))
#define LAS __attribute__((address_space(3)))
typedef unsigned short bf16;
typedef unsigned v4u __attribute__((ext_vector_type(4)));
typedef unsigned v2u __attribute__((ext_vector_type(2)));
typedef float f32x4 __attribute__((ext_vector_type(4)));
typedef float f32x16 __attribute__((ext_vector_type(16)));
typedef short bf16x8 __attribute__((ext_vector_type(8)));
#define LDS_WAIT() asm volatile("s_waitcnt lgkmcnt(0)" ::: "memory")
__device__ __forceinline__ unsigned pk2(float lo, float hi) { return pg8::cvt_pk_bf16(lo, hi); }
__device__ __forceinline__ float bf_lo(unsigned w) { return __uint_as_float(w << 16); }
__device__ __forceinline__ float bf_hi(unsigned w) { return __uint_as_float(w & 0xffff0000u); }
__device__ __forceinline__ float wave_sum(float v) {
#pragma unroll
    for (int o = 1; o < 64; o <<= 1) v += __shfl_xor(v, o);
    return v;
}

__device__ __forceinline__ void transpose_item(const float* W, int ldw, int n0, int k0, bf16* WT, int ldt, int r0, const float* gain, LAS float* scr, int lane) {
#pragma unroll 8
    for (int i = 0; i < 32; ++i) { const int kk = 2 * i + (lane >> 5); float v = W[(size_t)(k0 + kk) * ldw + n0 + (lane & 31)]; if (gain) v *= gain[k0 + kk]; scr[kk * 33 + (lane & 31)] = v; }
    LDS_WAIT(); asm volatile("" ::: "memory");
    const int c = lane & 7;
#pragma unroll
    for (int j = 0; j < 4; ++j) { const int n = (lane >> 3) + 8 * j; const LAS float* s = scr + (8 * c) * 33 + n;
        v4u o; o.x = pk2(s[0 * 33], s[1 * 33]); o.y = pk2(s[2 * 33], s[3 * 33]); o.z = pk2(s[4 * 33], s[5 * 33]); o.w = pk2(s[6 * 33], s[7 * 33]);
        *(v4u*)(WT + (size_t)(r0 + n) * ldt + k0 + 8 * c) = o; }
    LDS_WAIT(); asm volatile("" ::: "memory");
}
__device__ __forceinline__ void gu_item(const float* Wg, const float* Wu, const float* gain, bf16* WT, int r, LAS float* scr, int lane) {
    const int kb = r / 176, nb = r % 176, pn = nb >> 3, bj = (nb >> 2) & 1, j0 = (nb & 3) * 32;
    transpose_item(bj ? Wu : Wg, FF, 128 * pn + j0, kb * 64, WT, DM, nb * 32, gain, scr, lane);
}
struct Ptrs {
    const float *x, *g1, *Wg1, *Wu1, *Wd1, *gm, *Win, *sink, *pw, *pscale, *Wout, *g2, *Wg2, *Wu2, *Wd2, *gf;
    float* out;
    bf16 *WGU1, *WD1, *WGU2, *WD2, *WIN, *WOUT, *PWT, *XA, *HB, *HID, *Q, *K, *VT, *PC;
    float *ROPE, *SS0, *SS1, *SS2, *SS3;
};
__device__ __forceinline__ void p0_prologue(const Ptrs& P, LAS unsigned char* lds, int gw, int NGW, int wave, int lane) {
    LAS float* scr = (LAS float*)(lds + wave * 16384);
    constexpr int I_GU = 16 * 176, I_D = 44 * 32, I_IN = 16 * 40, I_OUT = 16 * 32, I_PW = 32;
    constexpr int NITEMS = 2 * I_GU + 2 * I_D + I_IN + I_OUT + I_PW;
    for (int it = gw; it < NITEMS; it += NGW) {
        int r = it;
        if (r < I_GU) { gu_item(P.Wg1, P.Wu1, P.g1, P.WGU1, r, scr, lane); continue; } r -= I_GU;
        if (r < I_GU) { gu_item(P.Wg2, P.Wu2, P.g2, P.WGU2, r, scr, lane); continue; } r -= I_GU;
        if (r < I_D) { transpose_item(P.Wd1, DM, (r & 31) * 32, (r >> 5) * 64, P.WD1, FF, (r & 31) * 32, nullptr, scr, lane); continue; } r -= I_D;
        if (r < I_D) { transpose_item(P.Wd2, DM, (r & 31) * 32, (r >> 5) * 64, P.WD2, FF, (r & 31) * 32, nullptr, scr, lane); continue; } r -= I_D;
        if (r < I_IN) { const int kb = r / 40, nb = r % 40; transpose_item(P.Win, INW, nb * 32, kb * 64, P.WIN, DM, nb * 32, P.gm, scr, lane); continue; } r -= I_IN;
        if (r < I_OUT) { transpose_item(P.Wout, DM, (r & 31) * 32, (r >> 5) * 64, P.WOUT, DM, (r & 31) * 32, nullptr, scr, lane); continue; } r -= I_OUT;
        { const int g = r >> 3, kb = (r >> 2) & 1, nb = r & 3; transpose_item(P.pw + (size_t)g * 16384, 128, nb * 32, kb * 64, P.PWT + (size_t)g * 16384, 128, nb * 32, nullptr, scr, lane); }
    }
    for (int m = gw; m < M; m += NGW) {
        const f32x4* xr = (const f32x4*)(P.x + (size_t)m * DM) + lane;
        f32x4 v[4]; float s = 0.f;
#pragma unroll
        for (int j = 0; j < 4; ++j) { v[j] = xr[64 * j]; s += (v[j][0] * v[j][0] + v[j][1] * v[j][1]) + (v[j][2] * v[j][2] + v[j][3] * v[j][3]); }
        const float tot = wave_sum(s);
        v2u* o8 = (v2u*)(P.XA + (size_t)m * DM) + lane;
#pragma unroll
        for (int j = 0; j < 4; ++j) { v2u w; w.x = pk2(v[j][0], v[j][1]); w.y = pk2(v[j][2], v[j][3]); o8[64 * j] = w; }
        if (lane < 4) ((f32x4*)(P.SS0 + (size_t)m * 16))[lane] = (f32x4){lane == 0 ? tot : 0.f, 0.f, 0.f, 0.f};
    }
    for (int i = gw * 64 + lane; i < SEQ * 8; i += NGW * 64) {
        const int pos = i >> 3, j = i & 7;
        const float inv = powf(500000.0f, -(float)j * 0.125f);
        const float ang = (float)pos * inv;
        const double a = (double)ang; const double kq = rint(a * 0.63661977236758134308);
        const double y = a - kq * 1.57079632679489661923; const double y2 = y * y;
        const double sy = y * (1.0 + y2 * (-1.0 / 6 + y2 * (1.0 / 120 + y2 * (-1.0 / 5040 + y2 * (1.0 / 362880 - y2 * (1.0 / 39916800))))));
        const double cy = 1.0 + y2 * (-0.5 + y2 * (1.0 / 24 + y2 * (-1.0 / 720 + y2 * (1.0 / 40320 + y2 * (-1.0 / 3628800 + y2 * (1.0 / 479001600))))));
        const int k4 = ((int)kq) & 3;
        const double cs = (k4 == 0) ? cy : (k4 == 1) ? -sy : (k4 == 2) ? -cy : sy;
        const double sn = (k4 == 0) ? sy : (k4 == 1) ? cy : (k4 == 2) ? -sy : -cy;
        P.ROPE[pos * 16 + j] = (float)cs; P.ROPE[pos * 16 + 8 + j] = (float)sn;
    }
}

__device__ __forceinline__ void attn_item(const Ptrs& P, int b, int kvh, int n, int g, int half, int lane) {
    const int ql = lane & 31, hi = lane >> 5, head = kvh * 4 + g, q0 = n * 128 + half * 64;
    const size_t rowbase = (size_t)b * SEQ;
    bf16x8 Qf[2][4];
#pragma unroll
    for (int qb = 0; qb < 2; ++qb)
#pragma unroll
        for (int ks = 0; ks < 4; ++ks) Qf[qb][ks] = *(const bf16x8*)(P.Q + (rowbase + q0 + 32 * qb + ql) * 512 + head * 64 + 16 * ks + 8 * hi);
    f32x16 O[2][2];
#pragma unroll
    for (int db = 0; db < 2; ++db)
#pragma unroll
        for (int qb = 0; qb < 2; ++qb)
#pragma unroll
            for (int v = 0; v < 16; ++v) O[db][qb][v] = 0.f;
    const float sk = P.sink[head] * 1.44269504089f;
    float mrun[2] = {sk, sk}, lrun[2] = {hi == 0 ? 1.f : 0.f, hi == 0 ? 1.f : 0.f};
    const int pr = 16 * (ql >> 4) + 8 * ((ql >> 2) & 1) + (ql & 3) + 4 * ((ql >> 3) & 1);
    const int t0 = q0 >> 5; const int kt_lo = (t0 - 4) < 0 ? 0 : (t0 - 4), kt_hi = (t0 + 5) > 127 ? 127 : (t0 + 5);
    const bf16* Kp = P.K + rowbase * 128 + kvh * 64 + 8 * hi;
    const bf16* Vp = P.VT + ((size_t)(b * 2 + kvh) * 64 + ql) * SEQ + 8 * hi;
    for (int kt = kt_lo; kt <= kt_hi; ++kt) {
        const int kbase = kt * 32;
        bf16x8 Kf[4], Vf[2][2];
#pragma unroll
        for (int ks = 0; ks < 4; ++ks) Kf[ks] = *(const bf16x8*)(Kp + (size_t)(kbase + pr) * 128 + 16 * ks);
#pragma unroll
        for (int db = 0; db < 2; ++db)
#pragma unroll
            for (int t = 0; t < 2; ++t) Vf[db][t] = *(const bf16x8*)(Vp + (size_t)db * 32 * SEQ + kbase + 16 * t);
        f32x16 S[2];
#pragma unroll
        for (int qb = 0; qb < 2; ++qb) {
#pragma unroll
            for (int v = 0; v < 16; ++v) S[qb][v] = 0.f;
#pragma unroll
            for (int ks = 0; ks < 4; ++ks) S[qb] = __builtin_amdgcn_mfma_f32_32x32x16_bf16(Kf[ks], Qf[qb][ks], S[qb], 0, 0, 0);
        }
        const bool edge = (kbase < q0 - 64) || (kbase > q0 + 96);
        if (edge) {
#pragma unroll
            for (int qb = 0; qb < 2; ++qb) { const int q = q0 + 32 * qb + ql;
#pragma unroll
                for (int v = 0; v < 16; ++v) { const int kk = kbase + 16 * (v >> 3) + 8 * hi + (v & 7); const int dd = q - kk; if (dd > 128 || dd < -128) S[qb][v] = -1e30f; } }
        }
        bf16x8 Pb[2][2];
#pragma unroll
        for (int qb = 0; qb < 2; ++qb) {
            float mt = S[qb][0];
#pragma unroll
            for (int v = 1; v < 16; ++v) mt = fmaxf(mt, S[qb][v]);
            mt = fmaxf(mt, __shfl_xor(mt, 32));
            const float mn = fmaxf(mrun[qb], mt); const float alpha = __builtin_amdgcn_exp2f(mrun[qb] - mn); mrun[qb] = mn;
            float ps = 0.f;
#pragma unroll
            for (int v = 0; v < 16; ++v) { const float p = __builtin_amdgcn_exp2f(S[qb][v] - mn); S[qb][v] = p; ps += p; }
            lrun[qb] = lrun[qb] * alpha + ps;
#pragma unroll
            for (int db = 0; db < 2; ++db)
#pragma unroll
                for (int v = 0; v < 16; ++v) O[db][qb][v] *= alpha;
#pragma unroll
            for (int t = 0; t < 2; ++t) { v4u w; w.x = pk2(S[qb][8 * t + 0], S[qb][8 * t + 1]); w.y = pk2(S[qb][8 * t + 2], S[qb][8 * t + 3]); w.z = pk2(S[qb][8 * t + 4], S[qb][8 * t + 5]); w.w = pk2(S[qb][8 * t + 6], S[qb][8 * t + 7]);
                Pb[qb][t] = __builtin_bit_cast(bf16x8, w); }
        }
#pragma unroll
        for (int db = 0; db < 2; ++db)
#pragma unroll
            for (int qb = 0; qb < 2; ++qb)
#pragma unroll
                for (int t = 0; t < 2; ++t) O[db][qb] = __builtin_amdgcn_mfma_f32_32x32x16_bf16(Vf[db][t], Pb[qb][t], O[db][qb], 0, 0, 0);
    }
#pragma unroll
    for (int qb = 0; qb < 2; ++qb) {
        const float lt = lrun[qb] + __shfl_xor(lrun[qb], 32); const float inv = 1.0f / lt;
        bf16* op = P.XA + (rowbase + q0 + 32 * qb + ql) * 1024 + head * 64 + 4 * hi;
#pragma unroll
        for (int db = 0; db < 2; ++db)
#pragma unroll
            for (int c = 0; c < 4; ++c) { v2u w; w.x = pk2(O[db][qb][4 * c + 0] * inv, O[db][qb][4 * c + 1] * inv); w.y = pk2(O[db][qb][4 * c + 2] * inv, O[db][qb][4 * c + 3] * inv);
                *(v2u*)(op + 32 * db + 8 * c) = w; }
    }
}
__device__ __forceinline__ void pool_item(const Ptrs& P, int tile, int g, int lane) {
    const int tl = lane & 31, hi = lane >> 5, t = tile * 32 + tl, s = t & (SEQ - 1), half = 1 << g;
    const int a1 = (s - half) < 0 ? 0 : (s - half), b1 = (s + half) > SEQ ? SEQ : (s + half);
    const int a2 = (s - half + 1) < 0 ? 0 : (s - half + 1), b2 = (s + half + 1) > SEQ ? SEQ : (s + half + 1);
    const float w1 = 0.5f / (float)(b1 - a1), w2 = 0.5f / (float)(b2 - a2);
    float acc[8][8];
#pragma unroll
    for (int ks = 0; ks < 8; ++ks)
#pragma unroll
        for (int e = 0; e < 8; ++e) acc[ks][e] = 0.f;
    const bf16* base = P.PC + (size_t)t * 512 + g * 128 + 8 * hi;
    for (int dl = -half; dl <= half; ++dl) {
        const int sp = s + dl; const bool valid = (sp >= 0) && (sp < SEQ);
        float w = (dl == -half) ? w1 : ((dl == half) ? w2 : (w1 + w2));
        if (!valid) w = 0.f;
        if (dl == 0) w -= 1.f;
        const bf16* p = base + (valid ? dl : 0) * 512;
#pragma unroll
        for (int ks = 0; ks < 8; ++ks) { const v4u raw = *(const v4u*)(p + 16 * ks);
            acc[ks][0] += w * bf_lo(raw.x); acc[ks][1] += w * bf_hi(raw.x); acc[ks][2] += w * bf_lo(raw.y); acc[ks][3] += w * bf_hi(raw.y);
            acc[ks][4] += w * bf_lo(raw.z); acc[ks][5] += w * bf_hi(raw.z); acc[ks][6] += w * bf_lo(raw.w); acc[ks][7] += w * bf_hi(raw.w); }
    }
    bf16x8 df[8];
#pragma unroll
    for (int ks = 0; ks < 8; ++ks) { v4u w; w.x = pk2(acc[ks][0], acc[ks][1]); w.y = pk2(acc[ks][2], acc[ks][3]); w.z = pk2(acc[ks][4], acc[ks][5]); w.w = pk2(acc[ks][6], acc[ks][7]); df[ks] = __builtin_bit_cast(bf16x8, w); }
    bf16* op = P.XA + (size_t)t * 1024 + 512 + g * 128 + 4 * hi;
    const float* scp = P.pscale + g * 128 + 4 * hi;
#pragma unroll
    for (int nb = 0; nb < 4; ++nb) {
        f32x16 o;
#pragma unroll
        for (int v = 0; v < 16; ++v) o[v] = 0.f;
#pragma unroll
        for (int ks = 0; ks < 8; ++ks) { const bf16x8 wf = *(const bf16x8*)(P.PWT + ((size_t)(g * 128 + 32 * nb + tl)) * 128 + 16 * ks + 8 * hi); o = __builtin_amdgcn_mfma_f32_32x32x16_bf16(wf, df[ks], o, 0, 0, 0); }
#pragma unroll
        for (int c = 0; c < 4; ++c) { const f32x4 sc = *(const f32x4*)(scp + 32 * nb + 8 * c);
            v2u w; w.x = pk2(o[4 * c + 0] * sc[0], o[4 * c + 1] * sc[1]); w.y = pk2(o[4 * c + 2] * sc[2], o[4 * c + 3] * sc[3]); *(v2u*)(op + 32 * nb + 8 * c) = w; }
    }
}

#define XB_TMO      128
#define XB_XCNT(j)  (256  + 64 * (j))
#define XB_XSUB(j)  (1280 + 64 * (j))
#define XB_XGEN(j)  (2304 + 64 * (j))
#define XB_TOP      3328
#define XB_TOPGEN   3392
#define XCD_BAR_WORDS 3456
#define XB_SPIN_CAP (1u << 18)

__device__ __forceinline__ unsigned xb_ld(unsigned* p)              { return __hip_atomic_load(p, __ATOMIC_RELAXED, __HIP_MEMORY_SCOPE_AGENT); }
__device__ __forceinline__ unsigned xb_add(unsigned* p, unsigned v) { return __hip_atomic_fetch_add(p, v, __ATOMIC_RELAXED, __HIP_MEMORY_SCOPE_AGENT); }
__device__ __forceinline__ unsigned xb_xcc_id() { return (unsigned)__builtin_amdgcn_s_getreg((3 << 11) | 20) & 0xFu; }
#define XB_SPIN(cond, bar) do { unsigned _sp = 0; while (cond) { __builtin_amdgcn_s_sleep(1); \
    if ((++_sp & 255u) == 0u) { if (xb_ld(&(bar)[XB_TMO])) break; if (_sp > XB_SPIN_CAP) { atomicAdd(&(bar)[XB_TMO], 1u); break; } } } } while (0)

struct XcdBarrier {
    unsigned* bar; unsigned x;
    volatile LAS unsigned* st;
};

__device__ __forceinline__ XcdBarrier xcd_barrier_post(unsigned* bar, volatile LAS unsigned* st) {
    XcdBarrier b; b.bar = bar; b.x = xb_xcc_id(); b.st = st;
    if (threadIdx.x == 0) (void)xb_add(&bar[XB_XCNT(b.x)], 1u);
    return b;
}
__device__ __forceinline__ void xcd_barrier_complete(unsigned* bar, unsigned x, unsigned& nloc, unsigned& nx) {
    const unsigned G = gridDim.x * gridDim.y * gridDim.z;
    unsigned sum, cnt, mine, sp = 0u;
    for (;;) {
        sum = 0u; cnt = 0u; mine = 0u;
#pragma unroll
        for (unsigned j = 0; j < 16; ++j) { const unsigned c = xb_ld(&bar[XB_XCNT(j)]); sum += c; cnt += (c > 0u) ? 1u : 0u; mine = (j == x) ? c : mine; }
        if (sum == G) break;
        __builtin_amdgcn_s_sleep(1);
        if ((++sp & 255u) == 0u) { if (xb_ld(&bar[XB_TMO])) break; if (sp > XB_SPIN_CAP) { atomicAdd(&bar[XB_TMO], 1u); break; } }
    }
    nloc = mine > 0u ? mine : 1u; nx = cnt > 0u ? cnt : 1u;
}

__device__ __forceinline__ void xcd_barrier(const XcdBarrier& b) {
    asm volatile("s_waitcnt vmcnt(0)" ::: "memory");
    __syncthreads();
    if (threadIdx.x == 0) {
        unsigned* bar = b.bar;
        __builtin_amdgcn_s_waitcnt(0);
        unsigned nloc = b.st[0], nx = b.st[1];
        if (nloc == 0u) { xcd_barrier_complete(bar, b.x, nloc, nx); b.st[0] = nloc; b.st[1] = nx; }
        const unsigned old = xb_add(&bar[XB_XSUB(b.x)], 1u);
        const unsigned gen = old / nloc;
        if (old + 1u == (gen + 1u) * nloc) {
            __builtin_amdgcn_fence(__ATOMIC_RELEASE, "agent");
            asm volatile("s_waitcnt vmcnt(0)" ::: "memory");
            const unsigned og = xb_add(&bar[XB_TOP], 1u);
            const unsigned tg = og / nx;
            if (og + 1u == (tg + 1u) * nx) xb_add(&bar[XB_TOPGEN], 1u);
            else XB_SPIN(xb_ld(&bar[XB_TOPGEN]) == tg, bar);
            __builtin_amdgcn_fence(__ATOMIC_ACQUIRE, "agent");
            xb_add(&bar[XB_XGEN(b.x)], 1u);
            asm volatile("s_waitcnt vmcnt(0)" ::: "memory");
        } else {
            XB_SPIN(xb_ld(&bar[XB_XGEN(b.x)]) == gen, bar);
            __builtin_amdgcn_fence(__ATOMIC_ACQUIRE, "agent");
            asm volatile("s_waitcnt vmcnt(0)" ::: "memory");
        }
    }
    __syncthreads();
}

struct Args { const float* in[16]; float* out; unsigned char* ws; int ph_lo, ph_hi; };
__global__ void __launch_bounds__(NTHR, 2) fwd_mega(Args args) {
    extern __shared__ __attribute__((aligned(16))) unsigned char lds_raw[];
    LAS unsigned char* lds = (LAS unsigned char*)lds_raw;
    cg::grid_group grid = cg::this_grid();
    const int tid = threadIdx.x, lane = tid & 63, wave = __builtin_amdgcn_readfirstlane(tid >> 6);
    const int G = gridDim.x, bx = blockIdx.x;
    const int gw = bx * NWAVES + wave, NGW = G * NWAVES;
    unsigned char* ws = args.ws;
    Ptrs P;
    P.x = args.in[0]; P.g1 = args.in[1]; P.Wg1 = args.in[2]; P.Wu1 = args.in[3]; P.Wd1 = args.in[4]; P.gm = args.in[5]; P.Win = args.in[6]; P.sink = args.in[7];
    P.pw = args.in[8]; P.pscale = args.in[9]; P.Wout = args.in[10]; P.g2 = args.in[11]; P.Wg2 = args.in[12]; P.Wu2 = args.in[13]; P.Wd2 = args.in[14]; P.gf = args.in[15];
    P.out = args.out;
    P.WGU1 = (bf16*)(ws + WS_WGU1); P.WD1 = (bf16*)(ws + WS_WD1); P.WGU2 = (bf16*)(ws + WS_WGU2); P.WD2 = (bf16*)(ws + WS_WD2); P.WIN = (bf16*)(ws + WS_WIN); P.WOUT = (bf16*)(ws + WS_WOUT);
    P.PWT = (bf16*)(ws + WS_PWT); P.XA = (bf16*)(ws + WS_A); P.HB = (bf16*)(ws + WS_B); P.HID = (bf16*)(ws + WS_HID);
    P.Q = (bf16*)(ws + WS_Q); P.K = (bf16*)(ws + WS_K); P.VT = (bf16*)(ws + WS_VT); P.PC = (bf16*)(ws + WS_PC);
    P.ROPE = (float*)(ws + WS_ROPE); P.SS0 = (float*)(ws + WS_SS0); P.SS1 = (float*)(ws + WS_SS1); P.SS2 = (float*)(ws + WS_SS2); P.SS3 = (float*)(ws + WS_SS3);
    const int lo = args.ph_lo, hi = args.ph_hi;
    volatile LAS unsigned* MISC = (volatile LAS unsigned*)(lds + 131072 + 320);
    if (tid < 32) MISC[tid] = 0u;
    __syncthreads();
    XcdBarrier bar = xcd_barrier_post((unsigned*)(ws + WS_CTL), MISC + 8);
#define IN(k) (lo <= (k) && (k) < hi)
#define SEAM(k) do { if (IN(k) && IN((k) + 1)) { if ((k) == 0) grid.sync(); else xcd_barrier(bar); if (PROBE_REP == 9 && (k) == 1) { for (int z = 0; z < 16; ++z) xcd_barrier(bar); } } } while (0)

    if (IN(0)) { for (int rep = 0; rep < REPS(0); ++rep) p0_prologue(P, lds, gw, NGW, wave, lane); SEAM(0); }
    if (IN(1)) {
        pg8::Gemm g{P.XA, P.WGU1, M, NGU, DM}; pg8::StaticOrder S; S.init(M, NGU, G, bx);
        pg8::EpiSwiglu E{P.HID, FF, P.SS0};
        if (REPS(1) == 2) pg8::gemm_phase<pg8::EpiSwiglu, pg8::StaticOrder, true, true>(lds, g, S, E);
        pg8::gemm_phase<pg8::EpiSwiglu, pg8::StaticOrder, true, true>(lds, g, S, E);
        SEAM(1);
    }
    if (IN(2)) {
        pg8::Gemm g{P.HID, P.WD1, M, DM, FF}; pg8::StaticOrder S; S.init(M, DM, G, bx);
        pg8::EpiResid<false> E{P.x, nullptr, P.HB, P.SS1, 0.5f};
        if (REPS(2) == 2) pg8::gemm_phase<pg8::EpiResid<false>, pg8::StaticOrder, true, true>(lds, g, S, E);
        pg8::gemm_phase<pg8::EpiResid<false>, pg8::StaticOrder, true, true>(lds, g, S, E);
        SEAM(2);
    }
    if (IN(3)) {
        pg8::Gemm g{P.HB, P.WIN, M, INW, DM}; pg8::StaticOrder S; S.init(M, INW, G, bx);
        pg8::EpiIn E{P.Q, P.K, P.VT, P.PC, P.SS1, P.ROPE};
        if (REPS(3) == 2) pg8::gemm_phase<pg8::EpiIn, pg8::StaticOrder, true, true>(lds, g, S, E);
        pg8::gemm_phase<pg8::EpiIn, pg8::StaticOrder, true, true>(lds, g, S, E);
        SEAM(3);
    }
    if (IN(4)) {
        for (int rep = 0; rep < REPS(4); ++rep) {
        for (int u = bx; u < BATCH * 2 * 32; u += G) { const int n = u & 31, kvh = (u >> 5) & 1, b = u >> 6; attn_item(P, b, kvh, n, wave >> 1, wave & 1, lane); }
        for (int it = gw; it < 2048; it += NGW) { const int tile = it & 1023, g = it >> 10; pool_item(P, tile, g, lane); pool_item(P, tile, 3 - g, lane); }
        }
        SEAM(4);
    }
    if (IN(5)) {
        pg8::Gemm g{P.XA, P.WOUT, M, DM, DM}; pg8::StaticOrder S; S.init(M, DM, G, bx);
        if (REPS(5) == 2) { pg8::EpiResid<true> E0{P.HB, nullptr, (bf16*)(ws + WS_HID), P.SS3, 1.0f}; pg8::gemm_phase<pg8::EpiResid<true>, pg8::StaticOrder, true, true>(lds, g, S, E0); }
        pg8::EpiResid<true> E{P.HB, nullptr, P.HB, P.SS2, 1.0f};
        pg8::gemm_phase<pg8::EpiResid<true>, pg8::StaticOrder, true, true>(lds, g, S, E);
        SEAM(5);
    }
    if (IN(6)) {
        pg8::Gemm g{P.HB, P.WGU2, M, NGU, DM}; pg8::StaticOrder S; S.init(M, NGU, G, bx);
        pg8::EpiSwiglu E{P.HID, FF, P.SS2};
        if (REPS(6) == 2) pg8::gemm_phase<pg8::EpiSwiglu, pg8::StaticOrder, true, true>(lds, g, S, E);
        pg8::gemm_phase<pg8::EpiSwiglu, pg8::StaticOrder, true, true>(lds, g, S, E);
        SEAM(6);
    }
    if (IN(7)) {
        pg8::Gemm g{P.HID, P.WD2, M, DM, FF}; pg8::StaticOrder S; S.init(M, DM, G, bx);
        if (REPS(7) == 2) { pg8::EpiResid<true> E0{P.HB, (float*)(ws + WS_A), nullptr, P.SS0, 0.5f}; pg8::gemm_phase<pg8::EpiResid<true>, pg8::StaticOrder, true, true>(lds, g, S, E0); }
        pg8::EpiResid<true> E{P.HB, P.out, nullptr, P.SS3, 0.5f};
        pg8::gemm_phase<pg8::EpiResid<true>, pg8::StaticOrder, true, true>(lds, g, S, E);
        SEAM(7);
    }
    if (IN(8)) {
        for (int rep = 0; rep < REPS(8); ++rep)
        for (int m = gw; m < M; m += NGW) {
            float q = P.SS3[(size_t)m * 16 + (lane & 15)];
            q += __shfl_xor(q, 1); q += __shfl_xor(q, 2); q += __shfl_xor(q, 4); q += __shfl_xor(q, 8);
            const float rs = 1.0f / sqrtf(q * (1.0f / 1024.0f) + pg8::RMS_EPS);
            f32x4* xr = (f32x4*)(P.out + (size_t)m * DM) + lane; const f32x4* gr = (const f32x4*)P.gf + lane;
#pragma unroll
            for (int j = 0; j < 4; ++j) { const f32x4 v = xr[64 * j]; f32x4* dst = (REPS(8) == 2 && rep == 0) ? ((f32x4*)(ws + WS_A) + (size_t)m * 256 + lane) : xr; dst[64 * j] = v * rs * gr[64 * j]; }
        }
    }
#undef IN
#undef SEAM
}

extern "C" void kernel_launch(void* const* d_in, const int* in_sizes, int n_in, void* d_out, int out_size, void* d_ws, size_t ws_size, hipStream_t stream) {
    static int grid = 0;
    if (grid == 0) {
        if (n_in != 16 || in_sizes[0] != M * DM || out_size != M * DM || ws_size < WS_END) { fprintf(stderr, "kernel_launch: unexpected shapes (n_in %d, in0 %d, out %d, ws %zu); nothing launched\n", n_in, n_in > 0 ? in_sizes[0] : -1, out_size, ws_size); grid = -1; return; }
        int dev = 0, cus = 0, per_cu = 0;
        if (hipGetDevice(&dev) != hipSuccess || hipDeviceGetAttribute(&cus, hipDeviceAttributeMultiprocessorCount, dev) != hipSuccess) { grid = -1; return; }
        if (hipFuncSetAttribute((const void*)fwd_mega, hipFuncAttributeMaxDynamicSharedMemorySize, LDS_BYTES) != hipSuccess) { fprintf(stderr, "kernel_launch: hipFuncSetAttribute failed\n"); grid = -1; return; }
        if (hipOccupancyMaxActiveBlocksPerMultiprocessor(&per_cu, (const void*)fwd_mega, NTHR, LDS_BYTES) != hipSuccess || per_cu < 1) { fprintf(stderr, "kernel_launch: occupancy query says %d blocks per CU\n", per_cu); (void)hipGetLastError(); grid = -1; return; }
        grid = cus * per_cu;
    }
    if (grid < 0) return;
    Args a{};
    for (int i = 0; i < 16; ++i) a.in[i] = (const float*)d_in[i];
    a.out = (float*)d_out; a.ws = (unsigned char*)d_ws;
#if MK_N_LAUNCHES == 1
    if (hipMemsetAsync((char*)d_ws + WS_CTL, 0, CTL_BYTES, stream) != hipSuccess) { fprintf(stderr, "kernel_launch: memset of the barrier words failed\n"); return; }
    a.ph_lo = 0; a.ph_hi = N_PHASES;
    void* kargs[] = {&a};
    hipError_t e = hipLaunchCooperativeKernel((const void*)fwd_mega, dim3(grid), dim3(NTHR), kargs, LDS_BYTES, stream);
    if (e != hipSuccess) fprintf(stderr, "kernel_launch: cooperative launch failed: %s (grid %d)\n", hipGetErrorString(e), grid);
#else
    for (int p = 0; p < N_PHASES; ++p) { a.ph_lo = p; a.ph_hi = p + 1; hipLaunchKernelGGL(fwd_mega, dim3(grid), dim3(NTHR), LDS_BYTES, stream, a); }
#endif
}
```
